# Optimizing an MI355X kernel written in HIP

```python
import jax, jax.numpy as jnp
from jax import lax
import numpy as np

D_MODEL = 2048
BATCH = 2
SEQ = 8192
DEPTH = 2

CHUNK = 64
N_MIXERS = 2
N_A_LAYERS = (DEPTH + 1) // 2
N_B_LAYERS = DEPTH // 2
EPS = 1e-6

D_FF = 5632

SGU_BLOCK = 128
SGU_WIDTH = 2 * D_MODEL
SGU_GROUPS = 8
SGU_GROUP_DIM = SGU_WIDTH // SGU_GROUPS

MLA_HEADS = 16
Q_LORA = 512
KV_LORA = 512
QK_NOPE = 128
QK_ROPE = 64
V_DIM = 128
QK_DIM = QK_NOPE + QK_ROPE
ROPE_THETA = 10000.0
Q_BLOCK = 128

kernel_name = "hybrid_sgu_mla_macaron_encoder"


def rmsnorm(x, g):
    xf = x.astype(jnp.float32)
    y = xf * lax.rsqrt(jnp.mean(xf * xf, axis=-1, keepdims=True) + EPS)
    return (y * g.astype(jnp.float32)).astype(x.dtype)


def layernorm(x, g, b):
    xf = x.astype(jnp.float32)
    mu = jnp.mean(xf, axis=-1, keepdims=True)
    var = jnp.mean(jnp.square(xf - mu), axis=-1, keepdims=True)
    y = (xf - mu) * lax.rsqrt(var + EPS)
    return (y * g.astype(jnp.float32) + b.astype(jnp.float32)).astype(x.dtype)


def swiglu(h, w_in, w_out):
    gate, up = jnp.split(h @ w_in, 2, axis=-1)
    return (jax.nn.silu(gate) * up) @ w_out


def rope(x, positions):
    half = x.shape[-1] // 2
    inv_freq = 1.0 / (ROPE_THETA ** (jnp.arange(half, dtype=jnp.float32) / half))
    ang = positions.astype(jnp.float32)[..., None] * inv_freq
    cos = jnp.cos(ang)[:, :, None, :]
    sin = jnp.sin(ang)[:, :, None, :]
    xf = x.astype(jnp.float32)
    x1, x2 = xf[..., :half], xf[..., half:]
    out = jnp.concatenate([x1 * cos - x2 * sin, x1 * sin + x2 * cos], axis=-1)
    return out.astype(x.dtype)


def sgu_mixer(h, w_in, v_gain, v_bias, w_spatial, b_spatial, w_out):
    B, S, _ = h.shape
    uv = jax.nn.gelu(h @ w_in)
    u, v = jnp.split(uv, 2, axis=-1)
    v = layernorm(v, v_gain, v_bias)
    nb = S // SGU_BLOCK
    v = v.reshape(B, nb, SGU_BLOCK, SGU_GROUPS, SGU_GROUP_DIM)
    pos_chunk = jnp.arange(SGU_BLOCK) // CHUNK
    mask = pos_chunk[:, None] >= pos_chunk[None, :]
    ws = jnp.where(mask[None], w_spatial, jnp.zeros_like(w_spatial))
    mixed = jnp.einsum('gij,bnjgc->bnigc', ws, v)
    mixed = mixed + b_spatial.T[None, None, :, :, None]
    gated = u * mixed.reshape(B, S, SGU_WIDTH)
    return gated @ w_out


def mla_mixer(h, positions, w_in, q_norm_g, w_q_up, kv_norm_g, w_kv_up, w_out):
    B, S, _ = h.shape
    proj = h @ w_in
    q_lat, kv_lat, k_rope = jnp.split(proj, [Q_LORA, Q_LORA + KV_LORA], axis=-1)
    q = (rmsnorm(q_lat, q_norm_g) @ w_q_up).reshape(B, S, MLA_HEADS, QK_DIM)
    q = jnp.concatenate([q[..., :QK_NOPE], rope(q[..., QK_NOPE:], positions)], axis=-1)
    q = q * (QK_DIM ** -0.5)
    k_rope = rope(k_rope[:, :, None, :], positions)
    kv = (rmsnorm(kv_lat, kv_norm_g) @ w_kv_up).reshape(B, S, MLA_HEADS, QK_NOPE + V_DIM)
    k_nope, v = kv[..., :QK_NOPE], kv[..., QK_NOPE:]
    k = jnp.concatenate(
        [k_nope, jnp.broadcast_to(k_rope, (B, S, MLA_HEADS, QK_ROPE))], axis=-1)

    nq = S // Q_BLOCK
    q_blocks = q.reshape(B, nq, Q_BLOCK, MLA_HEADS, QK_DIM).transpose(1, 0, 2, 3, 4)
    key_chunk = jnp.arange(S) // CHUNK

    def attend(args):
        qb, idx = args
        q_chunk = (idx * Q_BLOCK + jnp.arange(Q_BLOCK)) // CHUNK
        mask = key_chunk[None, :] <= q_chunk[:, None]
        s = jnp.einsum('bqhd,bkhd->bhqk', qb, k).astype(jnp.float32)
        s = jnp.where(mask[None, None], s, -jnp.inf)
        p = jax.nn.softmax(s, axis=-1).astype(v.dtype)
        return jnp.einsum('bhqk,bkhd->bqhd', p, v)

    o = lax.map(attend, (q_blocks, jnp.arange(nq)))
    o = o.transpose(1, 0, 2, 3, 4).reshape(B, S, MLA_HEADS * V_DIM)
    return o @ w_out


def setup_inputs(seed: int = 0) -> dict:
    key = jax.random.key(seed)
    ks = jax.random.split(key, 24)

    def nrm(k, shape, scale):
        return jax.random.normal(k, shape, jnp.float32) * scale

    def gain(k, shape):
        return 1.0 + 0.02 * jax.random.normal(k, shape, jnp.float32)

    x = jax.random.normal(ks[0], (BATCH, SEQ, D_MODEL), jnp.float32)
    offset = jax.random.randint(ks[1], (BATCH, 1), 0, 4096, dtype=jnp.int32)
    positions = offset + jnp.arange(SEQ, dtype=jnp.int32)[None, :]
    return {
        "x": x,
        "positions": positions,
        "ln_ffn1": gain(ks[2], (DEPTH, D_MODEL)),
        "ffn1_w_in": nrm(ks[3], (DEPTH, D_MODEL, 2 * D_FF), D_MODEL ** -0.5),
        "ffn1_w_out": nrm(ks[4], (DEPTH, D_FF, D_MODEL), D_FF ** -0.5),
        "ln_mix": gain(ks[5], (DEPTH, D_MODEL)),
        "ln_ffn2": gain(ks[6], (DEPTH, D_MODEL)),
        "ffn2_w_in": nrm(ks[7], (DEPTH, D_MODEL, 2 * D_FF), D_MODEL ** -0.5),
        "ffn2_w_out": nrm(ks[8], (DEPTH, D_FF, D_MODEL), D_FF ** -0.5),
        "sgu_w_in": nrm(ks[9], (N_A_LAYERS, D_MODEL, 2 * SGU_WIDTH), D_MODEL ** -0.5),
        "sgu_v_gain": gain(ks[10], (N_A_LAYERS, SGU_WIDTH)),
        "sgu_v_bias": nrm(ks[11], (N_A_LAYERS, SGU_WIDTH), 0.02),
        "sgu_w_spatial": nrm(ks[12], (N_A_LAYERS, SGU_GROUPS, SGU_BLOCK, SGU_BLOCK), SGU_BLOCK ** -0.5),
        "sgu_b_spatial": gain(ks[13], (N_A_LAYERS, SGU_GROUPS, SGU_BLOCK)),
        "sgu_w_out": nrm(ks[14], (N_A_LAYERS, SGU_WIDTH, D_MODEL), SGU_WIDTH ** -0.5),
        "mla_w_in": nrm(ks[15], (N_B_LAYERS, D_MODEL, Q_LORA + KV_LORA + QK_ROPE), D_MODEL ** -0.5),
        "mla_q_norm": gain(ks[16], (N_B_LAYERS, Q_LORA)),
        "mla_w_q_up": nrm(ks[17], (N_B_LAYERS, Q_LORA, MLA_HEADS * QK_DIM), Q_LORA ** -0.5),
        "mla_kv_norm": gain(ks[18], (N_B_LAYERS, KV_LORA)),
        "mla_w_kv_up": nrm(ks[19], (N_B_LAYERS, KV_LORA, MLA_HEADS * (QK_NOPE + V_DIM)), KV_LORA ** -0.5),
        "mla_w_out": nrm(ks[20], (N_B_LAYERS, MLA_HEADS * V_DIM, D_MODEL), (MLA_HEADS * V_DIM) ** -0.5),
        "ln_final": gain(ks[21], (D_MODEL,)),
    }


def reference(x, positions, ln_ffn1, ffn1_w_in, ffn1_w_out, ln_mix, ln_ffn2, ffn2_w_in, ffn2_w_out,
              sgu_w_in, sgu_v_gain, sgu_v_bias, sgu_w_spatial, sgu_b_spatial, sgu_w_out,
              mla_w_in, mla_q_norm, mla_w_q_up, mla_kv_norm, mla_w_kv_up, mla_w_out, ln_final):
    for i in range(DEPTH):
        x = x + 0.5 * swiglu(rmsnorm(x, ln_ffn1[i]), ffn1_w_in[i], ffn1_w_out[i])
        h = rmsnorm(x, ln_mix[i])
        j = i // N_MIXERS
        if i % N_MIXERS == 0:
            x = x + sgu_mixer(h, sgu_w_in[j], sgu_v_gain[j], sgu_v_bias[j],
                              sgu_w_spatial[j], sgu_b_spatial[j], sgu_w_out[j])
        else:
            x = x + mla_mixer(h, positions, mla_w_in[j], mla_q_norm[j], mla_w_q_up[j],
                              mla_kv_norm[j], mla_w_kv_up[j], mla_w_out[j])
        x = x + 0.5 * swiglu(rmsnorm(x, ln_ffn2[i]), ffn2_w_in[i], ffn2_w_out[i])
    return rmsnorm(x, ln_final)
```

```cpp
#include <hip/hip_runtime.h>
#include <hip/hip_cooperative_groups.h>
#include <cstdio>
#include <cstdint>
namespace cg = cooperative_groups;
namespace pg8 {
#define PG8_LAS __attribute__((address_space(3)))
typedef unsigned short bf16_t;
typedef short bf16x8 __attribute__((ext_vector_type(8)));
typedef float f32x4 __attribute__((ext_vector_type(4)));
typedef unsigned u32x4 __attribute__((ext_vector_type(4)));
constexpr int BM = 256, BK = 64, HALF = 128, HTB = HALF * BK * 2  , STAGE_BYTES = 8 * HTB, NXCD = 8, WGM = 8;

__host__ __device__ __forceinline__ int lds_byte(int r, int c) { const int st = (r >> 4) * 2 + (c >> 5), rr = r & 15, cc = c & 31, ob = rr * 64 + cc * 2; return st * 1024 + (ob ^ (((ob >> 9) & 1) << 5)); }
__host__ __device__ __forceinline__ void stage_rc(int b, int& R, int& C) { const int st = b / 1024, sb = b % 1024, swz = sb ^ (((sb >> 9) & 1) << 5); R = (st >> 1) * 16 + swz / 64; C = (st & 1) * 32 + (swz % 64) / 2; }
__host__ __device__ __forceinline__ int perm32(int rho) { const int n = rho >> 4, i = rho & 15; return 8 * (i >> 2) + 4 * n + (i & 3); }

struct Unit { int pm, pn; };
struct Gemm { const bf16_t* A; const bf16_t* Bt; int M, N, K; };

struct StaticOrder {
    int nM, nN, nwg, G, c;
    __host__ __device__ void init(int M, int N, int G_, int c_) { nM = M / BM; nN = N / BM; nwg = nM * nN; G = G_; c = c_; }
    __host__ __device__ bool next(int i, Unit& u) const {
        const long L = (long)i * G + c; if (L >= nwg) return false;
        int wgid = (int)L; { const int q = nwg / NXCD, r = nwg % NXCD, xcd = wgid % NXCD, off = wgid / NXCD; wgid = (xcd < r ? xcd * (q + 1) : r * (q + 1) + (xcd - r) * q) + off; }
        const int nig = WGM * nN, gid = wgid / nig, fm = gid * WGM, gsz = (nM - fm) < WGM ? (nM - fm) : WGM;
        u.pm = fm + ((wgid % nig) % gsz); u.pn = (wgid % nig) / gsz; return true;
    }
    __device__ __forceinline__ void a_ready(const Unit&) const {}
    __device__ __forceinline__ void done(const Unit&) const {}
};

__device__ __forceinline__ unsigned cvt_pk_bf16(float lo, float hi) { unsigned r; asm volatile("v_cvt_pk_bf16_f32 %0, %1, %2" : "=v"(r) : "v"(lo), "v"(hi)); return r; }
typedef float f32x2 __attribute__((ext_vector_type(2)));
__device__ __forceinline__ float fast_sigmoid(float x) { return __builtin_amdgcn_rcpf(1.0f + __builtin_amdgcn_exp2f(-1.4426950408889634f * x)); }
__device__ __forceinline__ float gelu_tanh(float x) { const float u = 0.7978845608028654f * (x + 0.044715f * x * x * x); return x * fast_sigmoid(2.0f * u); }
__device__ __forceinline__ float silu_f(float x) { return x * fast_sigmoid(x); }

template <int ACT  > struct EpiBf16 {
    static constexpr bool PERM = true, AFTER_DRAIN = false;
    bf16_t* O; int ldc; int split_cols; size_t split_stride;
    __device__ __forceinline__ void operator()(const f32x4 (&acc)[2][2][4][2], const Unit& u, int wr, int wc, int fr, int fq) const {
        const int row0 = u.pm * BM + wr * 64 + fr; int colt = u.pn * BM; bf16_t* base = O;
        if (split_cols) { const int t = colt / split_cols; base += (size_t)t * split_stride; colt -= t * split_cols; }
        const int col0 = colt + wc * 32 + 8 * fq;
#pragma unroll
        for (int ai = 0; ai < 2; ++ai)
#pragma unroll
            for (int m = 0; m < 4; ++m) { bf16_t* rowp = base + (size_t)(row0 + ai * HALF + m * 16) * ldc + col0;
#pragma unroll
                for (int bj = 0; bj < 2; ++bj) { f32x4 v0 = acc[ai][bj][m][0], v1 = acc[ai][bj][m][1];
                    if (ACT == 1) {
#pragma unroll
                        for (int e = 0; e < 4; ++e) { v0[e] = gelu_tanh(v0[e]); v1[e] = gelu_tanh(v1[e]); } }
                    u32x4 w; w.x = cvt_pk_bf16(v0[0], v0[1]); w.y = cvt_pk_bf16(v0[2], v0[3]); w.z = cvt_pk_bf16(v1[0], v1[1]); w.w = cvt_pk_bf16(v1[2], v1[3]);
                    *(u32x4*)(rowp + bj * HALF) = w; } }
    }
};
struct EpiSwiglu {
    static constexpr bool PERM = true, AFTER_DRAIN = false;
    bf16_t* O; int ldc;
    __device__ __forceinline__ void operator()(const f32x4 (&acc)[2][2][4][2], const Unit& u, int wr, int wc, int fr, int fq) const {
        const int row0 = u.pm * BM + wr * 64 + fr; const int col0 = u.pn * HALF + wc * 32 + 8 * fq;
#pragma unroll
        for (int ai = 0; ai < 2; ++ai)
#pragma unroll
            for (int m = 0; m < 4; ++m) { bf16_t* rowp = O + (size_t)(row0 + ai * HALF + m * 16) * ldc + col0;
                f32x4 g0 = acc[ai][0][m][0], g1 = acc[ai][0][m][1]; const f32x4 u0 = acc[ai][1][m][0], u1 = acc[ai][1][m][1];
#pragma unroll
                for (int e = 0; e < 4; ++e) { g0[e] = silu_f(g0[e]) * u0[e]; g1[e] = silu_f(g1[e]) * u1[e]; }
                u32x4 w; w.x = cvt_pk_bf16(g0[0], g0[1]); w.y = cvt_pk_bf16(g0[2], g0[3]); w.z = cvt_pk_bf16(g1[0], g1[1]); w.w = cvt_pk_bf16(g1[2], g1[3]);
                *(u32x4*)rowp = w; }
    }
};
struct EpiResid {
    static constexpr bool PERM = false, AFTER_DRAIN = false;
    const float* base; float* out; int ldc; float scale;
    __device__ __forceinline__ void operator()(const f32x4 (&acc)[2][2][4][2], const Unit& u, int wr, int wc, int fr, int fq) const {
        const int col0 = u.pn * BM + wc * 32 + 4 * fq;
#pragma unroll
        for (int ai = 0; ai < 2; ++ai)
#pragma unroll
            for (int m = 0; m < 4; ++m) { const size_t off = (size_t)(u.pm * BM + ai * HALF + wr * 64 + m * 16 + fr) * ldc + col0;
                f32x4 bs[2][2];
#pragma unroll
                for (int bj = 0; bj < 2; ++bj)
#pragma unroll
                    for (int n = 0; n < 2; ++n) bs[bj][n] = *(const f32x4*)(base + off + bj * HALF + n * 16);
#pragma unroll
                for (int bj = 0; bj < 2; ++bj)
#pragma unroll
                    for (int n = 0; n < 2; ++n) *(f32x4*)(out + off + bj * HALF + n * 16) = bs[bj][n] + acc[ai][bj][m][n] * scale;
                if (m & 1) asm volatile("" ::: "memory"); }
    }
};
template <class Epi, class Sched, bool ALIGN_EPI = false, bool SP2 = false>
__device__ __forceinline__ void gemm_phase(PG8_LAS unsigned char* lds, const Gemm g, const Sched& S, const Epi& E) {
    int tid_ = threadIdx.x; asm volatile("" : "+v"(tid_));
    const int tid = tid_, wid = __builtin_amdgcn_readfirstlane(tid >> 6), lane = tid & 63, wr = wid >> 2, wc = wid & 3, fr = lane & 15, fq = lane >> 4;
    const int K = g.K, nt = K / BK;
    unsigned voffA[2], voffB[2];
#pragma unroll
    for (int i = 0; i < 2; ++i) { int R, C; stage_rc(tid * 16 + i * 8192, R, C); const int Rb = Epi::PERM ? ((R & ~31) + perm32(R & 31)) : R;
        voffA[i] = (unsigned)(R * K + C) * 2u; voffB[i] = (unsigned)(Rb * K + C) * 2u; }
    const size_t kstep = (size_t)(BK * 2);
    const size_t hstep = (size_t)HALF * K * 2;
    const size_t tstep = 2 * hstep;
    const unsigned ldsw = (unsigned)wid * 1024u;
    const int aoff = lds_byte(wr * 64 + fr, fq * 8), boff = lds_byte(wc * 32 + fr, fq * 8);
#define PG8_SA(b, h) (((b) * 2 + (h)) * HTB)
#define PG8_SB(b, h) ((4 + (b) * 2 + (h)) * HTB)
#define PG8_STAGE(bufoff, gbase, voff) do { _Pragma("unroll") for (int _i = 0; _i < 2; ++_i) \
        __builtin_amdgcn_global_load_lds((const unsigned*)((const char*)(gbase) + (voff)[_i]), (PG8_LAS unsigned*)(lds + (bufoff) + ldsw + _i * 8192), 16, 0, 0); } while (0)
#define PG8_LDA(dst, b, h) do { _Pragma("unroll") for (int m = 0; m < 4; ++m) _Pragma("unroll") for (int k = 0; k < 2; ++k) dst[m][k] = *(const PG8_LAS bf16x8*)(lds + PG8_SA(b, h) + aoff + m * 2048 + k * 1024); } while (0)
#define PG8_LDB(dst, b, h) do { _Pragma("unroll") for (int n = 0; n < 2; ++n) _Pragma("unroll") for (int k = 0; k < 2; ++k) dst[n][k] = *(const PG8_LAS bf16x8*)(lds + PG8_SB(b, h) + boff + n * 2048 + k * 1024); } while (0)
#define PG8_MMA(ai, bj, At, Bt) do { __builtin_amdgcn_s_setprio(1); _Pragma("unroll") for (int m = 0; m < 4; ++m) _Pragma("unroll") for (int n = 0; n < 2; ++n) _Pragma("unroll") for (int k = 0; k < 2; ++k) \
        acc[ai][bj][m][n] = __builtin_amdgcn_mfma_f32_16x16x32_bf16(Bt[n][k], At[m][k], acc[ai][bj][m][n], 0, 0, 0); __builtin_amdgcn_s_setprio(0); } while (0)
#define PG8_WAIT_V(n) asm volatile("s_waitcnt vmcnt(" #n ")" ::: "memory")
#define PG8_WAIT_L(n) asm volatile("s_waitcnt lgkmcnt(" #n ")" ::: "memory")
#define PG8_BAR __builtin_amdgcn_s_barrier()
#define PG8_SCHED __builtin_amdgcn_sched_barrier(0)
    Unit cur, nxt; int ui = 0;
    if (!S.next(0, cur)) return;
    f32x4 acc[2][2][4][2];
#pragma unroll
    for (int a = 0; a < 2; ++a)
#pragma unroll
        for (int b = 0; b < 2; ++b)
#pragma unroll
            for (int m = 0; m < 4; ++m)
#pragma unroll
                for (int n = 0; n < 2; ++n) acc[a][b][m][n] = (f32x4){0.f, 0.f, 0.f, 0.f};
    bf16x8 At[4][2], B0[2][2], B1[2][2];
    const char* cA = (const char*)g.A + (size_t)cur.pm * tstep; const char* cB = (const char*)g.Bt + (size_t)cur.pn * tstep;
    S.a_ready(cur);
    if constexpr (SP2) {
        PG8_STAGE(PG8_SB(0, 0), cB, voffB); PG8_STAGE(PG8_SB(0, 1), cB + hstep, voffB); PG8_STAGE(PG8_SA(0, 0), cA, voffA); PG8_STAGE(PG8_SA(0, 1), cA + hstep, voffA);
        if (wr == 1) PG8_BAR;
        PG8_WAIT_V(2); PG8_BAR;
        PG8_STAGE(PG8_SB(1, 0), cB + kstep, voffB); PG8_STAGE(PG8_SA(1, 0), cA + kstep, voffA); PG8_STAGE(PG8_SB(1, 1), cB + hstep + kstep, voffB);
        PG8_WAIT_V(6); PG8_BAR;
    } else {
        PG8_STAGE(PG8_SB(0, 0), cB, voffB); PG8_STAGE(PG8_SA(0, 0), cA, voffA); PG8_STAGE(PG8_SB(0, 1), cB + hstep, voffB); PG8_STAGE(PG8_SA(0, 1), cA + hstep, voffA);
        if (wr == 1) PG8_BAR;
        PG8_WAIT_V(4); PG8_BAR;
        PG8_STAGE(PG8_SB(1, 0), cB + kstep, voffB); PG8_STAGE(PG8_SA(1, 0), cA + kstep, voffA); PG8_STAGE(PG8_SB(1, 1), cB + hstep + kstep, voffB);
        PG8_WAIT_V(6); PG8_BAR;
    }
    for (;;) {
        const bool has_next = S.next(ui + 1, nxt);
        const char* nA = has_next ? (const char*)g.A + (size_t)nxt.pm * tstep : cA; const char* nB = has_next ? (const char*)g.Bt + (size_t)nxt.pn * tstep : cB;
        for (int t = 0; t < nt; t += 2) {
            const bool last = (t == nt - 2);
            const char* a1 = cA + (size_t)(t + 1) * kstep;
            const char* a2 = last ? nA : cA + (size_t)(t + 2) * kstep; const char* b2 = last ? nB : cB + (size_t)(t + 2) * kstep;
            const char* a3 = a2 + kstep; const char* b3 = b2 + kstep;
            if (last && has_next) S.a_ready(nxt);
            if constexpr (SP2) {
            PG8_LDB(B0, 0, 0); PG8_LDB(B1, 0, 1); PG8_SCHED; PG8_LDA(At, 0, 0); PG8_STAGE(PG8_SA(1, 1), a1 + hstep, voffA);
            PG8_WAIT_V(8); PG8_WAIT_L(0); PG8_BAR; PG8_MMA(0, 0, At, B0); PG8_MMA(0, 1, At, B1); PG8_BAR; PG8_SCHED;
            PG8_LDA(At, 0, 1); PG8_STAGE(PG8_SB(0, 0), b2, voffB); PG8_STAGE(PG8_SB(0, 1), b2 + hstep, voffB); PG8_STAGE(PG8_SA(0, 0), a2, voffA);
            PG8_WAIT_V(8); PG8_WAIT_L(0); PG8_BAR; PG8_MMA(1, 0, At, B0); PG8_MMA(1, 1, At, B1); PG8_BAR; PG8_SCHED;
            PG8_LDB(B0, 1, 0); PG8_LDB(B1, 1, 1); PG8_SCHED; PG8_LDA(At, 1, 0); PG8_STAGE(PG8_SA(0, 1), a2 + hstep, voffA);
            PG8_WAIT_V(8); PG8_WAIT_L(0); PG8_BAR; PG8_MMA(0, 0, At, B0); PG8_MMA(0, 1, At, B1); PG8_BAR; PG8_SCHED;
            PG8_LDA(At, 1, 1); PG8_STAGE(PG8_SB(1, 0), b3, voffB); PG8_STAGE(PG8_SB(1, 1), b3 + hstep, voffB); PG8_STAGE(PG8_SA(1, 0), a3, voffA);
            PG8_WAIT_V(8); PG8_WAIT_L(0); PG8_BAR; PG8_MMA(1, 0, At, B0); PG8_MMA(1, 1, At, B1); PG8_BAR; PG8_SCHED;
            } else {
            PG8_LDB(B0, 0, 0); PG8_SCHED; PG8_LDA(At, 0, 0); PG8_STAGE(PG8_SA(1, 1), a1 + hstep, voffA);
            PG8_WAIT_L(8); PG8_BAR; PG8_WAIT_L(0); PG8_MMA(0, 0, At, B0); PG8_BAR; PG8_SCHED;
            PG8_LDB(B1, 0, 1); PG8_STAGE(PG8_SB(0, 0), b2, voffB);
            PG8_BAR; PG8_WAIT_L(0); PG8_MMA(0, 1, At, B1); PG8_BAR;
            PG8_LDA(At, 0, 1); PG8_STAGE(PG8_SA(0, 0), a2, voffA);
            PG8_BAR; PG8_WAIT_L(0); PG8_MMA(1, 0, At, B0); PG8_BAR; PG8_SCHED;
            PG8_STAGE(PG8_SB(0, 1), b2 + hstep, voffB);
            PG8_WAIT_V(6); PG8_BAR; PG8_MMA(1, 1, At, B1); PG8_BAR;
            PG8_LDB(B0, 1, 0); PG8_SCHED; PG8_LDA(At, 1, 0); PG8_STAGE(PG8_SA(0, 1), a2 + hstep, voffA);
            PG8_WAIT_L(8); PG8_BAR; PG8_WAIT_L(0); PG8_MMA(0, 0, At, B0); PG8_BAR; PG8_SCHED;
            PG8_LDB(B1, 1, 1); PG8_STAGE(PG8_SB(1, 0), b3, voffB);
            PG8_BAR; PG8_WAIT_L(0); PG8_MMA(0, 1, At, B1); PG8_BAR;
            PG8_LDA(At, 1, 1); PG8_STAGE(PG8_SA(1, 0), a3, voffA);
            PG8_BAR; PG8_WAIT_L(0); PG8_MMA(1, 0, At, B0); PG8_BAR; PG8_SCHED;
            PG8_STAGE(PG8_SB(1, 1), b3 + hstep, voffB);
            PG8_WAIT_V(6); PG8_BAR; PG8_MMA(1, 1, At, B1); PG8_BAR;
            }
        }
        if constexpr (ALIGN_EPI) { if (wr == 0) PG8_BAR; }
        if constexpr (!Epi::AFTER_DRAIN) { E(acc, cur, wr, wc, fr, fq); S.done(cur); }
        if (!has_next) break;
#pragma unroll
        for (int a = 0; a < 2; ++a)
#pragma unroll
            for (int b = 0; b < 2; ++b)
#pragma unroll
                for (int m = 0; m < 4; ++m)
#pragma unroll
                    for (int n = 0; n < 2; ++n) acc[a][b][m][n] = (f32x4){0.f, 0.f, 0.f, 0.f};
        cur = nxt; cA = nA; cB = nB; ++ui;
        if constexpr (ALIGN_EPI) { if (wr == 1) PG8_BAR; }
    }
    PG8_WAIT_V(0);
    if constexpr (!ALIGN_EPI) { if (wr == 0) PG8_BAR; }
    PG8_BAR;
    if constexpr (Epi::AFTER_DRAIN) { E.fused(acc, cur, wr, wc, fr, fq, lds, wid, lane); S.done(cur); }
#undef PG8_SA
#undef PG8_SB
#undef PG8_STAGE
#undef PG8_LDA
#undef PG8_LDB
#undef PG8_MMA
#undef PG8_WAIT_V
#undef PG8_WAIT_L
#undef PG8_BAR
#undef PG8_SCHED
}
}

#ifndef MK_PER_PHASE
#define MK_PER_PHASE 1
#endif
#define GAS __attribute__((address_space(1)))
#define LAS __attribute__((address_space(3)))
typedef unsigned short bf16;
typedef unsigned v4u __attribute__((ext_vector_type(4)));
typedef unsigned v2u __attribute__((ext_vector_type(2)));
typedef float f32x4 __attribute__((ext_vector_type(4)));
typedef float f32x2v __attribute__((ext_vector_type(2)));
typedef short bf16x8 __attribute__((ext_vector_type(8)));
typedef short s16x4 __attribute__((ext_vector_type(4)));
typedef float f32x16 __attribute__((ext_vector_type(16)));

constexpr int NWAVES = 8, NTHR = 512;
constexpr int M = 16384, SEQ = 8192, DM = 2048, FF = 5632, SW = 4096;
constexpr int NH = 16, QKD = 192, MLA_IN = 1088, MLA_INP = 1280, QUP_N = 3072, KVUP_N = 4096;
constexpr float EPS = 1e-6f;
constexpr float C2 = 0.07216878364870322f * 1.4426950408889634f;

constexpr size_t MiB = 1u << 20;
constexpr size_t WS_ROPE = 1 * MiB, WS_VST = 5 * MiB;
constexpr size_t WS_WFI = 8 * MiB, WFI_SZ = 44 * MiB, WS_WFO = 184 * MiB, WFO_SZ = 22 * MiB;
constexpr size_t WS_WSI = 272 * MiB, WS_WSO = 304 * MiB, WS_WMI = 320 * MiB, WS_WQU = 325 * MiB, WS_WKV = 328 * MiB, WS_WMO = 332 * MiB;
constexpr size_t WS_XN = 340 * MiB, WS_BIG = 404 * MiB, WS_PROJ = 660 * MiB, WS_QN = 700 * MiB, WS_KVN = 716 * MiB, WS_KR = 732 * MiB, WS_END = 734 * MiB;
constexpr int LDS_BYTES = 147456;

__device__ __forceinline__ float wave_sum(float v) {
#pragma unroll
    for (int o = 1; o < 64; o <<= 1) v += __shfl_xor(v, o);
    return v;
}
__device__ __forceinline__ unsigned pk2(float lo, float hi) { return pg8::cvt_pk_bf16(lo, hi); }
__device__ __forceinline__ float bflo(unsigned w) { return __uint_as_float(w << 16); }
__device__ __forceinline__ float bfhi(unsigned w) { return __uint_as_float(w & 0xffff0000u); }

__device__ __forceinline__ void transpose_item(const float* W, int K, int N, bf16* WT, int mode, float scale, LAS float* scr, int item, int lane) {
    const int nblk = N / 32, kb = item / nblk, nb = item % nblk, k0 = 64 * kb, n0 = 32 * nb;
    int drow0 = n0;
    if (mode == 1) { const int half = (n0 >= FF) ? 1 : 0; const int j = n0 - half * FF; drow0 = (j >> 7) * 256 + half * 128 + (j & 127); }
    float v[32];
    const float* src = W + (size_t)(k0 + (lane >> 5)) * N + n0 + (lane & 31);
#pragma unroll
    for (int i = 0; i < 32; ++i) v[i] = __builtin_nontemporal_load(src + (size_t)(2 * i) * N);
#pragma unroll
    for (int i = 0; i < 32; ++i) scr[(2 * i + (lane >> 5)) * 33 + (lane & 31)] = v[i] * scale;
    asm volatile("s_waitcnt lgkmcnt(0)" ::: "memory");
    const int c = lane & 7;
#pragma unroll
    for (int j = 0; j < 4; ++j) { const int n = (lane >> 3) + 8 * j; const LAS float* s = scr + (8 * c) * 33 + n;
        v4u o; o.x = pk2(s[0 * 33], s[1 * 33]); o.y = pk2(s[2 * 33], s[3 * 33]); o.z = pk2(s[4 * 33], s[5 * 33]); o.w = pk2(s[6 * 33], s[7 * 33]);
        *(v4u*)(WT + (size_t)(drow0 + n) * K + k0 + 8 * c) = o; }
    asm volatile("s_waitcnt lgkmcnt(0)" ::: "memory");
}
__device__ __forceinline__ void transpose_matrix(const float* W, int K, int N, bf16* WT, int mode, float scale, LAS float* scr, int gw, int NGW, int lane) {
    const int items = (K / 64) * (N / 32);
    for (int it = gw; it < items; it += NGW) transpose_item(W, K, N, WT, mode, scale, scr, it, lane);
}

__device__ __forceinline__ void rms_row_bf16(const float* xrow, const float* g, bf16* orow, int lane) {
    const f32x4* xr = (const f32x4*)xrow + lane; const f32x4* gr = (const f32x4*)g + lane;
    f32x4 v[8]; float s = 0.f;
#pragma unroll
    for (int j = 0; j < 8; ++j) { v[j] = xr[64 * j]; s += (v[j].x * v[j].x + v[j].y * v[j].y) + (v[j].z * v[j].z + v[j].w * v[j].w); }
    const float rstd = 1.0f / sqrtf(wave_sum(s) * (1.f / DM) + EPS);
    v2u* o8 = (v2u*)orow + lane;
#pragma unroll
    for (int j = 0; j < 8; ++j) { const f32x4 gg = gr[64 * j]; v2u o; o.x = pk2(v[j].x * rstd * gg.x, v[j].y * rstd * gg.y); o.y = pk2(v[j].z * rstd * gg.z, v[j].w * rstd * gg.w); o8[64 * j] = o; }
}
__device__ __forceinline__ void rms_row_f32(const float* xrow, const float* g, float* orow, int lane) {
    const f32x4* xr = (const f32x4*)xrow + lane; const f32x4* gr = (const f32x4*)g + lane;
    f32x4 v[8]; float s = 0.f;
#pragma unroll
    for (int j = 0; j < 8; ++j) { v[j] = xr[64 * j]; s += (v[j].x * v[j].x + v[j].y * v[j].y) + (v[j].z * v[j].z + v[j].w * v[j].w); }
    const float rstd = 1.0f / sqrtf(wave_sum(s) * (1.f / DM) + EPS);
    f32x4* o = (f32x4*)orow + lane;
#pragma unroll
    for (int j = 0; j < 8; ++j) { const f32x4 gg = gr[64 * j]; o[64 * j] = v[j] * rstd * gg; }
}
__device__ __forceinline__ void vstat_row(const bf16* vrow, f32x2v* st, int lane) {
    const v4u* p = (const v4u*)vrow + lane;
    v4u w[8]; float s = 0.f;
#pragma unroll
    for (int j = 0; j < 8; ++j) { w[j] = p[64 * j];
#pragma unroll
        for (int e = 0; e < 4; ++e) s += bflo(w[j][e]) + bfhi(w[j][e]); }
    const float mean = wave_sum(s) * (1.f / SW); float q = 0.f;
#pragma unroll
    for (int j = 0; j < 8; ++j)
#pragma unroll
        for (int e = 0; e < 4; ++e) { const float a = bflo(w[j][e]) - mean, b = bfhi(w[j][e]) - mean; q += a * a + b * b; }
    const float rstd = 1.0f / sqrtf(wave_sum(q) * (1.f / SW) + EPS);
    if (lane == 0) *st = (f32x2v){mean, rstd};
}
__device__ __forceinline__ void mla_norm_row(const bf16* prow, const float* gq, const float* gkv, const f32x2v* tabrow, bf16* qn, bf16* kvn, bf16* kr, int lane) {
    const v4u wq = ((const v4u*)prow)[lane], wk = ((const v4u*)(prow + 512))[lane];
    float q[8], k[8]; float sq = 0.f, sk = 0.f;
#pragma unroll
    for (int e = 0; e < 4; ++e) { q[2 * e] = bflo(wq[e]); q[2 * e + 1] = bfhi(wq[e]); k[2 * e] = bflo(wk[e]); k[2 * e + 1] = bfhi(wk[e]); }
#pragma unroll
    for (int e = 0; e < 8; ++e) { sq += q[e] * q[e]; sk += k[e] * k[e]; }
    const float rq = 1.0f / sqrtf(wave_sum(sq) * (1.f / 512) + EPS), rk = 1.0f / sqrtf(wave_sum(sk) * (1.f / 512) + EPS);
    const f32x4 gq0 = ((const f32x4*)gq)[2 * lane], gq1 = ((const f32x4*)gq)[2 * lane + 1], gk0 = ((const f32x4*)gkv)[2 * lane], gk1 = ((const f32x4*)gkv)[2 * lane + 1];
    v4u oq, ok;
    oq.x = pk2(q[0] * rq * gq0.x, q[1] * rq * gq0.y); oq.y = pk2(q[2] * rq * gq0.z, q[3] * rq * gq0.w); oq.z = pk2(q[4] * rq * gq1.x, q[5] * rq * gq1.y); oq.w = pk2(q[6] * rq * gq1.z, q[7] * rq * gq1.w);
    ok.x = pk2(k[0] * rk * gk0.x, k[1] * rk * gk0.y); ok.y = pk2(k[2] * rk * gk0.z, k[3] * rk * gk0.w); ok.z = pk2(k[4] * rk * gk1.x, k[5] * rk * gk1.y); ok.w = pk2(k[6] * rk * gk1.z, k[7] * rk * gk1.w);
    ((v4u*)qn)[lane] = oq; ((v4u*)kvn)[lane] = ok;
    if (lane < 32) {
        const float x1 = __uint_as_float((unsigned)prow[1024 + lane] << 16), x2 = __uint_as_float((unsigned)prow[1056 + lane] << 16);
        const f32x2v cs = tabrow[lane];
        const unsigned w = pk2(x1 * cs.x - x2 * cs.y, x1 * cs.y + x2 * cs.x);
        kr[lane] = (bf16)(w & 0xffffu); kr[32 + lane] = (bf16)(w >> 16);
    }
}

__device__ __forceinline__ void sgu_spatial_phase(LAS unsigned char* lds, bf16* U, const bf16* V, const f32x2v* vst, const float* gain, const float* bias, const float* wsp, const float* bsp, int G, int bx) {
    constexpr int P = 272;
    LAS unsigned char* WsL = lds; LAS unsigned char* VT = lds + 128 * P;
    int tid_ = threadIdx.x; asm volatile("" : "+v"(tid_));
    const int tid = tid_, lane = tid & 63, fr = lane & 15, fq = lane >> 4; const int wid = __builtin_amdgcn_readfirstlane(tid >> 6);
    int cur_g = -1;
    for (int unit = bx; unit < 4096; unit += G) {
        const int g = unit & 7, p = unit >> 3, nb = p >> 2, chunk = p & 3;
        __syncthreads();
        if (g != cur_g) {
#pragma unroll
            for (int i = 0; i < 8; ++i) { const int e4 = tid + 512 * i; f32x4 w = *(const f32x4*)(wsp + (size_t)g * 16384 + (size_t)e4 * 4); const int row = e4 >> 5, j = (e4 & 31) * 4;
                if ((row >> 6) < (j >> 6)) w = (f32x4){0.f, 0.f, 0.f, 0.f};
                *(LAS v2u*)(WsL + row * P + j * 2) = (v2u){pk2(w.x, w.y), pk2(w.z, w.w)}; }
            cur_g = g;
        }
        const size_t row0 = (size_t)nb * 128; const int cbase = g * 512 + chunk * 128;
        { const int cc = tid & 15, jp = tid >> 4;
          const f32x4 ga0 = *(const f32x4*)(gain + cbase + cc * 8), ga1 = *(const f32x4*)(gain + cbase + cc * 8 + 4), bi0 = *(const f32x4*)(bias + cbase + cc * 8), bi1 = *(const f32x4*)(bias + cbase + cc * 8 + 4);
#pragma unroll
          for (int half = 0; half < 2; ++half) { const int j = 64 * half + 2 * jp;
              const v4u w0 = *(const v4u*)(V + (row0 + j) * SW + cbase + cc * 8), w1 = *(const v4u*)(V + (row0 + j + 1) * SW + cbase + cc * 8);
              const f32x2v s0 = vst[row0 + j], s1 = vst[row0 + j + 1];
#pragma unroll
              for (int e = 0; e < 4; ++e) { const float gA = e < 2 ? ga0[2 * e] : ga1[2 * e - 4], gB = e < 2 ? ga0[2 * e + 1] : ga1[2 * e - 3], bA = e < 2 ? bi0[2 * e] : bi1[2 * e - 4], bB = e < 2 ? bi0[2 * e + 1] : bi1[2 * e - 3];
                  const float y0a = (bflo(w0[e]) - s0.x) * s0.y * gA + bA, y1a = (bflo(w1[e]) - s1.x) * s1.y * gA + bA;
                  const float y0b = (bfhi(w0[e]) - s0.x) * s0.y * gB + bB, y1b = (bfhi(w1[e]) - s1.x) * s1.y * gB + bB;
                  *(LAS unsigned*)(VT + (cc * 8 + 2 * e) * P + j * 2) = pk2(y0a, y1a);
                  *(LAS unsigned*)(VT + (cc * 8 + 2 * e + 1) * P + j * 2) = pk2(y0b, y1b); } } }
        __syncthreads();
        const int i0 = wid * 16; const int nks = (i0 < 64) ? 2 : 4;
        bf16x8 wf[4];
#pragma unroll
        for (int ks = 0; ks < 4; ++ks) wf[ks] = *(const LAS bf16x8*)(WsL + (i0 + fr) * P + (32 * ks + 8 * fq) * 2);
        const float bsv = bsp[g * 128 + i0 + fr];
#pragma unroll
        for (int c4 = 0; c4 < 4; ++c4) {
            f32x4 acc[2];
#pragma unroll
            for (int n = 0; n < 2; ++n) { acc[n] = (f32x4){0.f, 0.f, 0.f, 0.f}; const int vrow = c4 * 32 + 8 * (fr >> 2) + 4 * n + (fr & 3);
#pragma unroll
                for (int ks = 0; ks < 4; ++ks) if (ks < nks) { const bf16x8 vf = *(const LAS bf16x8*)(VT + vrow * P + (32 * ks + 8 * fq) * 2); acc[n] = __builtin_amdgcn_mfma_f32_16x16x32_bf16(vf, wf[ks], acc[n], 0, 0, 0); } }
            bf16* up = U + (row0 + i0 + fr) * SW + cbase + c4 * 32 + 8 * fq;
            const v4u uw = *(const v4u*)up; v4u o;
            o.x = pk2(bflo(uw.x) * (acc[0][0] + bsv), bfhi(uw.x) * (acc[0][1] + bsv)); o.y = pk2(bflo(uw.y) * (acc[0][2] + bsv), bfhi(uw.y) * (acc[0][3] + bsv));
            o.z = pk2(bflo(uw.z) * (acc[1][0] + bsv), bfhi(uw.z) * (acc[1][1] + bsv)); o.w = pk2(bflo(uw.w) * (acc[1][2] + bsv), bfhi(uw.w) * (acc[1][3] + bsv));
            *(v4u*)up = o;
        }
    }
    __syncthreads();
}

__device__ __forceinline__ int crow(int r, int hi) { return (r & 3) + 8 * (r >> 2) + 4 * hi; }
__device__ __forceinline__ void attn_unit(int b, int h, int qb, const bf16* Q, const bf16* KV, const bf16* KR, const f32x2v* tab, bf16* O, LAS unsigned char* lds) {
    constexpr int KP = 400, KBUF = 64 * KP, VBUF = 16384, BUF = KBUF + VBUF;
    int tid_ = threadIdx.x; asm volatile("" : "+v"(tid_));
    const int tid = tid_, lane = tid & 63, r32 = lane & 31, hi = lane >> 5; const int wid = __builtin_amdgcn_readfirstlane(tid >> 6);
    const size_t rowbase = (size_t)b * SEQ; const int q0 = qb * 256;
    const int NT = 4 * qb + 4, my_last = 4 * qb + (wid >> 1);
    LAS float* wsf = (LAS float*)(lds + 2 * BUF) + wid * 64;
    const int srow0 = tid >> 4, sch = tid & 15, krow = tid >> 3, kch = tid & 7;
    v4u sk[2], sv[2], skr;
#define ATT_LOAD(kt) do { const size_t m0_ = rowbase + (size_t)(kt) * 64; \
        _Pragma("unroll") for (int i_ = 0; i_ < 2; ++i_) { const bf16* src_ = KV + (m0_ + srow0 + 32 * i_) * KVUP_N + h * 256 + sch * 8; sk[i_] = *(const v4u*)src_; sv[i_] = *(const v4u*)(src_ + 128); } \
        skr = *(const v4u*)(KR + (m0_ + krow) * 64 + kch * 8); } while (0)
#define ATT_STORE(buf) do { LAS unsigned char* Kb_ = lds + (buf) * BUF; LAS unsigned char* Vb_ = Kb_ + KBUF; \
        _Pragma("unroll") for (int i_ = 0; i_ < 2; ++i_) { const int row_ = srow0 + 32 * i_; *(LAS v4u*)(Kb_ + row_ * KP + sch * 16) = sk[i_]; \
            *(LAS v4u*)(Vb_ + (sch >> 2) * 4096 + (row_ >> 3) * 512 + (row_ & 7) * 64 + (sch & 3) * 16) = sv[i_]; } \
        *(LAS v4u*)(Kb_ + krow * KP + 256 + kch * 16) = skr; } while (0)
    ATT_LOAD(0);
    const size_t qrow = rowbase + q0 + wid * 32 + r32;
    const bf16* Qp = Q + qrow * QUP_N + h * QKD + hi * 8;
    v4u qr[12];
#pragma unroll
    for (int d0 = 0; d0 < 12; ++d0) qr[d0] = *(const v4u*)(Qp + d0 * 16);
#pragma unroll
    for (int dd = 0; dd < 2; ++dd) { const f32x4* cs = (const f32x4*)(tab + qrow * 32 + 16 * dd + 8 * hi);
#pragma unroll
        for (int jj = 0; jj < 4; ++jj) { const f32x4 t = cs[jj]; const unsigned a = qr[8 + dd][jj], c = qr[10 + dd][jj];
            const float x1l = bflo(a), x1h = bfhi(a), x2l = bflo(c), x2h = bfhi(c);
            qr[8 + dd][jj] = pk2(x1l * t.x - x2l * t.y, x1h * t.z - x2h * t.w);
            qr[10 + dd][jj] = pk2(x1l * t.y + x2l * t.x, x1h * t.w + x2h * t.z); } }
    float mhat = 0.f, lsum = 0.f; f32x16 o[4];
#pragma unroll
    for (int c = 0; c < 4; ++c)
#pragma unroll
        for (int r = 0; r < 16; ++r) o[c][r] = 0.f;
    ATT_STORE(0);
    __syncthreads();
    for (int kt = 0; kt < NT; ++kt) {
        const int cur = kt & 1;
        if (kt + 1 < NT) ATT_LOAD(kt + 1);
        if (kt <= my_last) {
            const LAS unsigned char* Kb = lds + cur * BUF + r32 * KP + hi * 16; const LAS unsigned char* Vb = lds + cur * BUF + KBUF;
            f32x16 p0, p1; { const float nm = -mhat;
#pragma unroll
                for (int r = 0; r < 16; ++r) { p0[r] = nm; p1[r] = nm; } }
            bf16x8 kf[6][4];
#define KLD(g) do { kf[g][0] = *(const LAS bf16x8*)(Kb + (2 * (g)) * 32); kf[g][1] = *(const LAS bf16x8*)(Kb + 32 * KP + (2 * (g)) * 32); \
                    kf[g][2] = *(const LAS bf16x8*)(Kb + (2 * (g) + 1) * 32); kf[g][3] = *(const LAS bf16x8*)(Kb + 32 * KP + (2 * (g) + 1) * 32); } while (0)
            KLD(0);
#pragma unroll
            for (int g = 0; g < 6; ++g) {
                if (g + 1 < 6) KLD(g + 1);
                __builtin_amdgcn_sched_barrier(0);
                const bf16x8 qa = __builtin_bit_cast(bf16x8, qr[2 * g]), qb_ = __builtin_bit_cast(bf16x8, qr[2 * g + 1]);
                p0 = __builtin_amdgcn_mfma_f32_32x32x16_bf16(kf[g][0], qa, p0, 0, 0, 0); p1 = __builtin_amdgcn_mfma_f32_32x32x16_bf16(kf[g][1], qa, p1, 0, 0, 0);
                p0 = __builtin_amdgcn_mfma_f32_32x32x16_bf16(kf[g][2], qb_, p0, 0, 0, 0); p1 = __builtin_amdgcn_mfma_f32_32x32x16_bf16(kf[g][3], qb_, p1, 0, 0, 0);
                __builtin_amdgcn_sched_barrier(0);
            }
#undef KLD
            float rm = fmaxf(p0[0], p1[0]);
#pragma unroll
            for (int r = 1; r < 16; ++r) rm = fmaxf(rm, fmaxf(p0[r], p1[r]));
            { auto rr = __builtin_amdgcn_permlane32_swap(__float_as_uint(rm), __float_as_uint(rm), false, false); rm = fmaxf(__uint_as_float(rr[0]), __uint_as_float(rr[1])); }
            const bool first = (kt == 0);
            if (first || __any(rm > 8.0f)) {
                const float dl = first ? rm : fmaxf(rm, 0.f);
                mhat += dl;
#pragma unroll
                for (int r = 0; r < 16; ++r) { p0[r] -= dl; p1[r] -= dl; }
                if (!first) {
                    const float f = __builtin_amdgcn_exp2f(-dl); lsum *= f;
                    if (hi == 0) wsf[r32] = f;
#pragma unroll
                    for (int r = 0; r < 16; ++r) { const float fr_ = wsf[crow(r, hi)];
#pragma unroll
                        for (int c = 0; c < 4; ++c) o[c][r] *= fr_; }
                }
            }
            float sacc = 0.f;
#pragma unroll
            for (int r = 0; r < 16; ++r) { p0[r] = __builtin_amdgcn_exp2f(p0[r]); p1[r] = __builtin_amdgcn_exp2f(p1[r]); sacc += p0[r] + p1[r]; }
            lsum += sacc;
            v4u pw[4];
#pragma unroll
            for (int w = 0; w < 4; ++w) { pw[0][w] = pk2(p0[2 * w], p0[2 * w + 1]); pw[1][w] = pk2(p0[8 + 2 * w], p0[9 + 2 * w]); pw[2][w] = pk2(p1[2 * w], p1[2 * w + 1]); pw[3][w] = pk2(p1[8 + 2 * w], p1[9 + 2 * w]); }
            const LAS unsigned char* vp = Vb + (4 * hi + ((lane & 15) >> 2)) * 64 + ((lane >> 4) & 1) * 32 + (lane & 3) * 8;
            s16x4 vlo[4][4], vhh[4][4];
#define VLD(c) do { _Pragma("unroll") for (int ks_ = 0; ks_ < 4; ++ks_) { \
                vlo[c][ks_] = __builtin_bit_cast(s16x4, __builtin_amdgcn_ds_read_tr16_b64_v4i16((LAS s16x4*)(vp + (c) * 4096 + ks_ * 1024))); \
                vhh[c][ks_] = __builtin_bit_cast(s16x4, __builtin_amdgcn_ds_read_tr16_b64_v4i16((LAS s16x4*)(vp + (c) * 4096 + ks_ * 1024 + 512))); } } while (0)
            VLD(0);
#pragma unroll
            for (int c = 0; c < 4; ++c) {
                if (c + 1 < 4) VLD(c + 1);
                __builtin_amdgcn_sched_barrier(0);
#pragma unroll
                for (int ks = 0; ks < 4; ++ks) {
                    const s16x4 lo = vlo[c][ks], hh = vhh[c][ks];
                    const bf16x8 vf = (bf16x8){lo[0], lo[1], lo[2], lo[3], hh[0], hh[1], hh[2], hh[3]};
                    o[c] = __builtin_amdgcn_mfma_f32_32x32x16_bf16(__builtin_bit_cast(bf16x8, pw[ks]), vf, o[c], 0, 0, 0); }
                __builtin_amdgcn_sched_barrier(0);
            }
#undef VLD
        }
        if (kt + 1 < NT) ATT_STORE(cur ^ 1);
        __syncthreads();
    }
    { auto rr = __builtin_amdgcn_permlane32_swap(__float_as_uint(lsum), __float_as_uint(lsum), false, false); lsum = __uint_as_float(rr[0]) + __uint_as_float(rr[1]); }
    if (hi == 0) wsf[32 + r32] = lsum;
    bf16* Ow = O + (rowbase + q0 + wid * 32) * DM + h * 128 + r32;
#pragma unroll
    for (int r = 0; r < 16; ++r) { const int orow = crow(r, hi); const float rl = __builtin_amdgcn_rcpf(wsf[32 + orow]);
#pragma unroll
        for (int c = 0; c < 4; c += 1) { const unsigned w = pk2(o[c][r] * rl, 0.f); Ow[(size_t)orow * DM + 32 * c] = (bf16)(w & 0xffffu); } }
#undef ATT_LOAD
#undef ATT_STORE
}
__device__ __forceinline__ void attn_phase(LAS unsigned char* lds, const bf16* Q, const bf16* KV, const bf16* KR, const f32x2v* tab, bf16* O, int G, int bx) {
    for (int i = 0;; ++i) { const int idx = i * G + bx; if (idx >= 1024) break;
        const int i4 = idx >> 8, v0 = idx & 255, v = (v0 & 7) * 32 + (v0 >> 3), bh = v >> 3, s = v & 7;
        const int qb = i4 == 0 ? 31 - s : i4 == 1 ? 16 + s : i4 == 2 ? 15 - s : s;
        attn_unit(bh >> 4, bh & 15, qb, Q, KV, KR, tab, O, lds); }
}

struct Args { const void* in[22]; float* out; unsigned char* ws; int ph_lo, ph_hi, coop, pad; };
constexpr int NPHASES = 25;

__global__ void __launch_bounds__(NTHR, 2) mk_fwd(Args a) {
    extern __shared__ __attribute__((aligned(16))) unsigned char lds_raw[];
    LAS unsigned char* lds = (LAS unsigned char*)lds_raw;
    cg::grid_group grid = cg::this_grid();
    const int G = gridDim.x;
#define KARG_PTR(i) ((const void*)((const volatile unsigned long long __attribute__((address_space(4)))*)__builtin_amdgcn_kernarg_segment_ptr())[(i)])
#define KARG_INT(i) (((const volatile int __attribute__((address_space(4)))*)__builtin_amdgcn_kernarg_segment_ptr())[48 + (i)])
#define IN_F(i) ((const float*)KARG_PTR(i))
#define OUT_P ((float*)KARG_PTR(22))
#define WS_P ((unsigned char*)KARG_PTR(23))
#define NGW (G * NWAVES)
    const int ph_lo = KARG_INT(0), ph_hi = KARG_INT(1), coop = KARG_INT(2);
    int ph = 0;
#define BEGIN_PHASE if (ph_lo <= ph && ph < ph_hi) { unsigned char* ws = WS_P; float* out = OUT_P; bf16* XN = (bf16*)(ws + WS_XN); bf16* BIG = (bf16*)(ws + WS_BIG); f32x2v* TAB = (f32x2v*)(ws + WS_ROPE); f32x2v* VST = (f32x2v*)(ws + WS_VST); int tid_ = threadIdx.x, bx_ = blockIdx.x; asm volatile("" : "+v"(tid_), "+s"(bx_)); const int tid = tid_, bx = bx_, lane = tid & 63, wave = __builtin_amdgcn_readfirstlane(tid >> 6), gw = bx * NWAVES + wave; (void)bx; (void)out; (void)XN; (void)BIG; (void)TAB; (void)VST; (void)lane; (void)tid; (void)wave; (void)gw;
#define END_PHASE if (coop && ph + 1 < ph_hi) grid.sync(); } ++ph;

    BEGIN_PHASE
        LAS float* scr = (LAS float*)(lds + wave * 16384);
        for (int i = 0; i < 2; ++i) for (int w = 0; w < 2; ++w) {
            transpose_matrix((w ? IN_F(7) : IN_F(3)) + (size_t)i * DM * 2 * FF, DM, 2 * FF, (bf16*)(ws + WS_WFI + (size_t)(2 * i + w) * WFI_SZ), 1, 1.f, scr, gw, NGW, lane);
            transpose_matrix((w ? IN_F(8) : IN_F(4)) + (size_t)i * FF * DM, FF, DM, (bf16*)(ws + WS_WFO + (size_t)(2 * i + w) * WFO_SZ), 0, 1.f, scr, gw, NGW, lane);
        }
        transpose_matrix(IN_F(9), DM, 2 * SW, (bf16*)(ws + WS_WSI), 0, 1.f, scr, gw, NGW, lane);
        transpose_matrix(IN_F(14), SW, DM, (bf16*)(ws + WS_WSO), 0, 1.f, scr, gw, NGW, lane);
        transpose_matrix(IN_F(15), DM, MLA_IN, (bf16*)(ws + WS_WMI), 0, 1.f, scr, gw, NGW, lane);
        transpose_matrix(IN_F(17), 512, QUP_N, (bf16*)(ws + WS_WQU), 0, C2, scr, gw, NGW, lane);
        transpose_matrix(IN_F(19), 512, KVUP_N, (bf16*)(ws + WS_WKV), 0, 1.f, scr, gw, NGW, lane);
        transpose_matrix(IN_F(20), DM, DM, (bf16*)(ws + WS_WMO), 0, 1.f, scr, gw, NGW, lane);
        { v4u* padp = (v4u*)(ws + WS_WMI + (size_t)MLA_IN * DM * 2); const int npad = (MLA_INP - MLA_IN) * DM * 2 / 16;
          for (int i = bx * NTHR + tid; i < npad; i += G * NTHR) padp[i] = (v4u){0u, 0u, 0u, 0u}; }
        for (int idx = bx * NTHR + tid; idx < M * 32; idx += G * NTHR) { const int m = idx >> 5, f = idx & 31;
            const float inv = __builtin_amdgcn_exp2f(-(float)f * (13.287712379549449f / 32.f)); const float ang = (float)((const int*)KARG_PTR(1))[m] * inv;
            double rev = (double)ang * 0.15915494309189535; rev -= __builtin_rint(rev); const float fr = (float)rev;
            TAB[idx] = (f32x2v){__builtin_amdgcn_cosf(fr), __builtin_amdgcn_sinf(fr)}; }
    END_PHASE

#pragma nounroll
    for (int f = 0; f < 4; ++f) {
        const int layer = f >> 1, which = f & 1;
        BEGIN_PHASE
            const float* src = (f == 0) ? IN_F(0) : out; const float* g = (which ? IN_F(6) : IN_F(2)) + layer * DM;
            for (int m = gw; m < M; m += NGW) rms_row_bf16(src + (size_t)m * DM, g, XN + (size_t)m * DM, lane);
        END_PHASE
        BEGIN_PHASE
            pg8::Gemm gm{XN, (const bf16*)(ws + WS_WFI + (size_t)f * WFI_SZ), M, 2 * FF, DM}; pg8::StaticOrder S; S.init(M, 2 * FF, G, bx);
            pg8::EpiSwiglu E{BIG, FF};
#ifndef DIS_G0
            pg8::gemm_phase<pg8::EpiSwiglu, pg8::StaticOrder, true, true>(lds, gm, S, E);
#endif
        END_PHASE
        BEGIN_PHASE
            pg8::Gemm gm{BIG, (const bf16*)(ws + WS_WFO + (size_t)f * WFO_SZ), M, DM, FF}; pg8::StaticOrder S; S.init(M, DM, G, bx);
            pg8::EpiResid E{(f == 0) ? IN_F(0) : (const float*)out, out, DM, 0.5f};
#ifndef DIS_G1
            pg8::gemm_phase<pg8::EpiResid, pg8::StaticOrder, true, true>(lds, gm, S, E);
#endif
        END_PHASE
        if (which == 0) {
            BEGIN_PHASE
                const float* g = IN_F(5) + layer * DM;
                for (int m = gw; m < M; m += NGW) rms_row_bf16(out + (size_t)m * DM, g, XN + (size_t)m * DM, lane);
            END_PHASE
            int mix_sel = 0;
            if (layer == 0) {
                BEGIN_PHASE
                    pg8::Gemm gm{XN, (const bf16*)(ws + WS_WSI), M, 2 * SW, DM}; pg8::StaticOrder S; S.init(M, 2 * SW, G, bx);
                    pg8::EpiBf16<1> E{BIG, SW, SW, (size_t)M * SW};
#ifndef DIS_G2
                    pg8::gemm_phase<pg8::EpiBf16<1>, pg8::StaticOrder, true, true>(lds, gm, S, E);
#endif
                END_PHASE
                BEGIN_PHASE
                    for (int m = gw; m < M; m += NGW) vstat_row(BIG + (size_t)M * SW + (size_t)m * SW, VST + m, lane);
                END_PHASE
                BEGIN_PHASE
#ifndef DIS_SGU
                    sgu_spatial_phase(lds, BIG, BIG + (size_t)M * SW, VST, IN_F(10), IN_F(11), IN_F(12), IN_F(13), G, bx);
#endif
                END_PHASE
                mix_sel = 0;
            } else {
#define PROJ ((bf16*)(ws + WS_PROJ))
#define QN ((bf16*)(ws + WS_QN))
#define KVN ((bf16*)(ws + WS_KVN))
#define KR ((bf16*)(ws + WS_KR))
#define Qb BIG
#define KVb (BIG + (size_t)M * QUP_N)
#define Ob XN
                BEGIN_PHASE
                    pg8::Gemm gm{XN, (const bf16*)(ws + WS_WMI), M, MLA_INP, DM}; pg8::StaticOrder S; S.init(M, MLA_INP, G, bx);
                    pg8::EpiBf16<0> E{PROJ, MLA_INP, 0, 0};
#ifndef DIS_G3
                    pg8::gemm_phase<pg8::EpiBf16<0>, pg8::StaticOrder, true, true>(lds, gm, S, E);
#endif
                END_PHASE
                BEGIN_PHASE
                    for (int m = gw; m < M; m += NGW) mla_norm_row(PROJ + (size_t)m * MLA_INP, IN_F(16), IN_F(18), TAB + (size_t)m * 32, QN + (size_t)m * 512, KVN + (size_t)m * 512, KR + (size_t)m * 64, lane);
                END_PHASE
                BEGIN_PHASE
                    { pg8::Gemm gm{QN, (const bf16*)(ws + WS_WQU), M, QUP_N, 512}; pg8::StaticOrder S; S.init(M, QUP_N, G, bx);
                      pg8::EpiBf16<0> E{Qb, QUP_N, 0, 0};
#ifndef DIS_G4
                      pg8::gemm_phase<pg8::EpiBf16<0>, pg8::StaticOrder, true, true>(lds, gm, S, E);
#endif
}
                    { pg8::Gemm gm{KVN, (const bf16*)(ws + WS_WKV), M, KVUP_N, 512}; pg8::StaticOrder S; S.init(M, KVUP_N, G, bx);
                      pg8::EpiBf16<0> E{KVb, KVUP_N, 0, 0};
#ifndef DIS_G5
                      pg8::gemm_phase<pg8::EpiBf16<0>, pg8::StaticOrder, true, true>(lds, gm, S, E);
#endif
}
                END_PHASE
                BEGIN_PHASE
#ifndef DIS_ATTN
                    attn_phase(lds, Qb, KVb, KR, TAB, Ob, G, bx);
#endif
                END_PHASE
                mix_sel = 1;
            }
            BEGIN_PHASE
                pg8::Gemm gm{mix_sel ? XN : BIG, (const bf16*)(ws + (mix_sel ? WS_WMO : WS_WSO)), M, DM, mix_sel ? DM : SW}; pg8::StaticOrder S; S.init(M, DM, G, bx);
                pg8::EpiResid E{out, out, DM, 1.0f};
#ifndef DIS_G6
                pg8::gemm_phase<pg8::EpiResid, pg8::StaticOrder, true, true>(lds, gm, S, E);
#endif
            END_PHASE
        }
    }
    BEGIN_PHASE
        const float* g = IN_F(21);
        for (int m = gw; m < M; m += NGW) rms_row_f32(out + (size_t)m * DM, g, out + (size_t)m * DM, lane);
    END_PHASE
#undef BEGIN_PHASE
#undef END_PHASE
}

extern "C" void kernel_launch(void* const* d_in, const int* in_sizes, int n_in, void* d_out, int out_size, void* d_ws, size_t ws_size, hipStream_t stream) {
    static int grid = 0;
    if (grid == 0) {
        if (n_in != 22 || in_sizes[0] != M * DM || out_size != M * DM || ws_size < WS_END) { fprintf(stderr, "kernel_launch: unexpected shapes (n_in %d, in0 %d, out %d, ws %zu)\n", n_in, n_in > 0 ? in_sizes[0] : -1, out_size, ws_size); grid = -1; return; }
        int dev = 0, cus = 0, per_cu = 0;
        if (hipGetDevice(&dev) != hipSuccess || hipDeviceGetAttribute(&cus, hipDeviceAttributeMultiprocessorCount, dev) != hipSuccess) { grid = -1; return; }
        if (hipFuncSetAttribute((const void*)mk_fwd, hipFuncAttributeMaxDynamicSharedMemorySize, LDS_BYTES) != hipSuccess) { fprintf(stderr, "kernel_launch: hipFuncSetAttribute failed\n"); grid = -1; return; }
        if (hipOccupancyMaxActiveBlocksPerMultiprocessor(&per_cu, (const void*)mk_fwd, NTHR, LDS_BYTES) != hipSuccess || per_cu < 1) { fprintf(stderr, "kernel_launch: occupancy query says %d blocks per CU\n", per_cu); per_cu = 1; }
        (void)hipGetLastError();
        grid = cus;
    }
    if (grid < 0) return;
    Args a{};
    for (int i = 0; i < 22; ++i) a.in[i] = d_in[i];
    a.out = (float*)d_out; a.ws = (unsigned char*)d_ws;
#if MK_PER_PHASE
    for (int ph = 0; ph < NPHASES; ++ph) { a.ph_lo = ph; a.ph_hi = ph + 1; a.coop = 0;
        hipLaunchKernelGGL(mk_fwd, dim3(grid), dim3(NTHR), LDS_BYTES, stream, a); }
#else
    a.ph_lo = 0; a.ph_hi = NPHASES; a.coop = 1;
    void* args[] = {&a};
    hipError_t e = hipLaunchCooperativeKernel((const void*)mk_fwd, dim3(grid), dim3(NTHR), args, LDS_BYTES, stream);
    if (e != hipSuccess) fprintf(stderr, "kernel_launch: cooperative launch failed: %s (grid %d)\n", hipGetErrorString(e), grid);
#endif
}
```

```cpp
#include <hip/hip_runtime.h>
#include <hip/hip_cooperative_groups.h>
#include <cstdio>
#include <cstdint>
namespace cg = cooperative_groups;
constexpr int NWAVES = 8, NTHR = 512;
constexpr int M = 16384, SEQ = 8192, DM = 2048, FF = 5632, SW = 4096;
constexpr int NH = 16, QKD = 192, MLA_IN = 1088, MLA_INP = 1280, QUP_N = 3072, KVUP_N = 4096;
constexpr float EPS = 1e-6f;
constexpr float C2 = 0.07216878364870322f * 1.4426950408889634f;

constexpr size_t MiB = 1u << 20;
constexpr size_t WS_ROPE = 1 * MiB;
constexpr size_t WS_RSS = 5 * MiB, RSS_SZ = 131072, WS_QSS = WS_RSS + 7 * RSS_SZ, WS_KVSS = WS_QSS + RSS_SZ, WS_VSUM = WS_KVSS + RSS_SZ, WS_VSQ = WS_VSUM + RSS_SZ, WS_STAT_END = WS_VSQ + RSS_SZ;
constexpr size_t WS_WFI = 8 * MiB, WFI_SZ = 44 * MiB, WS_WFO = 184 * MiB, WFO_SZ = 22 * MiB;
constexpr size_t WS_WSI = 272 * MiB, WS_WSO = 304 * MiB, WS_WMI = 320 * MiB, WS_WQU = 325 * MiB, WS_WKV = 328 * MiB, WS_WMO = 332 * MiB;
constexpr size_t WS_XN = 340 * MiB, WS_BIG = 404 * MiB, WS_PROJ = 660 * MiB, WS_O = 700 * MiB, WS_KR = 764 * MiB, WS_END = 766 * MiB;
constexpr int LDS_BYTES = 147456;

#define GAS __attribute__((address_space(1)))
#define KARG_U64(i) (((const volatile unsigned long long __attribute__((address_space(4)))*)__builtin_amdgcn_kernarg_segment_ptr())[(i)])
#define KARG_PTR(i) ((const void*)(const GAS void*)KARG_U64(i))
#define KARG_INT(i) (((const volatile int __attribute__((address_space(4)))*)__builtin_amdgcn_kernarg_segment_ptr())[48 + (i)])
#define IN_F(i) ((const float*)KARG_PTR(i))
#define OUT_P ((float*)KARG_PTR(22))
#define WS_P ((unsigned char*)KARG_PTR(23))
typedef unsigned long long u64_t;
__device__ __forceinline__ void stat_add(u64_t* p, float v) { atomicAdd(p, (u64_t)__float2ll_rn(v * 16777216.0f)); }
__device__ __forceinline__ float stat_get(u64_t v) { return (float)(long long)v * (1.0f / 16777216.0f); }
__device__ __forceinline__ float xrow_sum(float v) {
    { auto r = __builtin_amdgcn_permlane16_swap(__float_as_uint(v), __float_as_uint(v), false, false); v = __uint_as_float(r[0]) + __uint_as_float(r[1]); }
    { auto r = __builtin_amdgcn_permlane32_swap(__float_as_uint(v), __float_as_uint(v), false, false); v = __uint_as_float(r[0]) + __uint_as_float(r[1]); }
    return v;
}
namespace pg8 {
#define PG8_LAS __attribute__((address_space(3)))
typedef unsigned short bf16_t;
typedef short bf16x8 __attribute__((ext_vector_type(8)));
typedef float f32x4 __attribute__((ext_vector_type(4)));
typedef unsigned u32x4 __attribute__((ext_vector_type(4)));
typedef unsigned u32x2 __attribute__((ext_vector_type(2)));
constexpr int BM = 256, BK = 64, HALF = 128, HTB = HALF * BK * 2  , STAGE_BYTES = 8 * HTB, NXCD = 8, WGM = 8;

__host__ __device__ __forceinline__ int lds_byte(int r, int c) { const int st = (r >> 4) * 2 + (c >> 5), rr = r & 15, cc = c & 31, ob = rr * 64 + cc * 2; return st * 1024 + (ob ^ (((ob >> 9) & 1) << 5)); }
__host__ __device__ __forceinline__ void stage_rc(int b, int& R, int& C) { const int st = b / 1024, sb = b % 1024, swz = sb ^ (((sb >> 9) & 1) << 5); R = (st >> 1) * 16 + swz / 64; C = (st & 1) * 32 + (swz % 64) / 2; }
__host__ __device__ __forceinline__ int perm32(int rho) { const int n = rho >> 4, i = rho & 15; return 8 * (i >> 2) + 4 * n + (i & 3); }

struct Unit { int pm, pn; };
struct Gemm { const bf16_t* A; const bf16_t* Bt; int M, N, K, lda; int ldb; unsigned a_pn_step, b_pn_step; };

struct StaticOrder {
    int nM, nN, nwg, G, c;
    __host__ __device__ void init(int M, int N, int G_, int c_) { nM = M / BM; nN = N / BM; nwg = nM * nN; G = G_; c = c_; }
    __host__ __device__ bool next(int i, Unit& u) const {
        const long L = (long)i * G + c; if (L >= nwg) return false;
        int wgid = (int)L; { const int q = nwg / NXCD, r = nwg % NXCD, xcd = wgid % NXCD, off = wgid / NXCD; wgid = (xcd < r ? xcd * (q + 1) : r * (q + 1) + (xcd - r) * q) + off; }
        const int nig = WGM * nN, gid = wgid / nig, fm = gid * WGM, gsz = (nM - fm) < WGM ? (nM - fm) : WGM;
        u.pm = fm + ((wgid % nig) % gsz); u.pn = (wgid % nig) / gsz; return true;
    }
    __device__ __forceinline__ void a_ready(const Unit&) const {}
    __device__ __forceinline__ void done(const Unit&) const {}
};

__device__ __forceinline__ unsigned cvt_pk_bf16(float lo, float hi) { unsigned r; asm volatile("v_cvt_pk_bf16_f32 %0, %1, %2" : "=v"(r) : "v"(lo), "v"(hi)); return r; }
typedef float f32x2 __attribute__((ext_vector_type(2)));
__device__ __forceinline__ float fast_sigmoid(float x) { return __builtin_amdgcn_rcpf(1.0f + __builtin_amdgcn_exp2f(-1.4426950408889634f * x)); }
__device__ __forceinline__ float gelu_tanh(float x) { const float k1 = -2.0f * 0.7978845608028654f * 1.4426950408889634f, k2 = k1 * 0.044715f;
    const float p = __builtin_fmaf(k2, x * x, k1); return x * __builtin_amdgcn_rcpf(1.0f + __builtin_amdgcn_exp2f(p * x)); }
__device__ __forceinline__ float silu_f(float x) { return x * fast_sigmoid(x); }

constexpr float RS_EPS = 1e-6f;
__device__ __forceinline__ float row_rstd(float ss, float inv_n) { return __builtin_amdgcn_rsqf(ss * inv_n + RS_EPS); }
__device__ __forceinline__ void rss_prefetch(PG8_LAS unsigned char* xl, const u64_t* rss, const Unit& u, int wr, int wid, int lane) {
#pragma unroll
    for (int j = 0; j < 4; ++j) __builtin_amdgcn_global_load_lds((const unsigned*)(rss + u.pm * BM + (j >> 1) * HALF + wr * 64) + (j & 1) * 64 + lane, (PG8_LAS unsigned*)(xl + wid * 1024 + j * 256), 4, 0, 0);
}
__device__ __forceinline__ void rss_wait() { asm volatile("s_waitcnt vmcnt(16)" ::: "memory"); }
__device__ __forceinline__ float rss_read(const PG8_LAS unsigned char* xl, int wid, int ai, int m, int fr) {
    const u32x2 w = *(const PG8_LAS u32x2*)(xl + wid * 1024 + ai * 512 + (m * 16 + fr) * 8); return __builtin_fmaf((float)w.y, 256.0f, (float)w.x * (1.0f / 16777216.0f)); }
template <int ACT  , int STAT> struct EpiBf16 {
    static constexpr bool PERM = true, AFTER_DRAIN = false;
    unsigned o_off; int ldc; int split_cols; unsigned split_stride;
    unsigned rss_off; float inv_n; unsigned st0_off, st1_off;
    __device__ __forceinline__ void prefetch(PG8_LAS unsigned char* xl, const Unit& u, int wr, int wid, int lane) const { rss_prefetch(xl, (const u64_t*)(WS_P + rss_off), u, wr, wid, lane); }
    __device__ __forceinline__ void operator()(const f32x4 (&acc)[2][2][4][2], const Unit& u, int wr, int wc, int fr, int fq, const PG8_LAS unsigned char* xl, int wid) const {
        rss_wait();
        unsigned char* ws_ = WS_P; u64_t* st0 = (u64_t*)(ws_ + st0_off); u64_t* st1 = (u64_t*)(ws_ + st1_off);
        const int row0 = u.pm * BM + wr * 64 + fr; int colt = u.pn * BM; bf16_t* base = (bf16_t*)(ws_ + o_off); int t = 0;
        if (split_cols) { t = colt / split_cols; base += (size_t)t * split_stride; colt -= t * split_cols; }
        const int col0 = colt + wc * 32 + 8 * fq;
        const bool do_stat = (STAT == 1) ? (t == 1) : (STAT == 2) ? (u.pn < 4) : false;
#pragma unroll
        for (int ai = 0; ai < 2; ++ai)
#pragma unroll
            for (int m = 0; m < 4; ++m) { const int row = row0 + ai * HALF + m * 16; bf16_t* rowp = base + (size_t)row * ldc + col0;
                const float rs = row_rstd(rss_read(xl, wid, ai, m, fr), inv_n); float s1 = 0.f, s2 = 0.f;
#pragma unroll
                for (int bj = 0; bj < 2; ++bj) { f32x4 v0 = acc[ai][bj][m][0] * rs, v1 = acc[ai][bj][m][1] * rs;
                    if (ACT == 1) {
                        const float k1 = -2.0f * 0.7978845608028654f * 1.4426950408889634f, k2 = k1 * 0.044715f;
                        f32x4 z0 = (v0 * v0 * k2 + k1) * v0, z1 = (v1 * v1 * k2 + k1) * v1;
#pragma unroll
                        for (int e = 0; e < 4; ++e) { z0[e] = __builtin_amdgcn_exp2f(z0[e]); z1[e] = __builtin_amdgcn_exp2f(z1[e]); }
                        z0 = z0 + 1.0f; z1 = z1 + 1.0f;
#pragma unroll
                        for (int e = 0; e < 4; ++e) { z0[e] = __builtin_amdgcn_rcpf(z0[e]); z1[e] = __builtin_amdgcn_rcpf(z1[e]); }
                        v0 = v0 * z0; v1 = v1 * z1; }
                    if (STAT != 0) { const f32x4 t1 = v0 + v1, t2 = v0 * v0 + v1 * v1; s1 += (t1[0] + t1[1]) + (t1[2] + t1[3]); s2 += (t2[0] + t2[1]) + (t2[2] + t2[3]); }
                    u32x4 w; w.x = cvt_pk_bf16(v0[0], v0[1]); w.y = cvt_pk_bf16(v0[2], v0[3]); w.z = cvt_pk_bf16(v1[0], v1[1]); w.w = cvt_pk_bf16(v1[2], v1[3]);
                    *(u32x4*)(rowp + bj * HALF) = w; }
                if (STAT != 0) { if (do_stat) {
                    s1 = xrow_sum(s1); s2 = xrow_sum(s2);
                    if (fq == 0) { if (STAT == 1) { stat_add(st0 + row, s1); stat_add(st1 + row, s2); } else stat_add((u.pn < 2 ? st0 : st1) + row, s2); } } } }
    }
};
struct EpiPartial {
    static constexpr bool PERM = true, AFTER_DRAIN = false;
    unsigned o_off;
    __device__ __forceinline__ void prefetch(PG8_LAS unsigned char*, const Unit&, int, int, int) const {}
    __device__ __forceinline__ void operator()(const f32x4 (&acc)[2][2][4][2], const Unit& u, int wr, int wc, int fr, int fq, const PG8_LAS unsigned char*, int) const {
        if (wc < 2) { float* P = (float*)(WS_P + o_off) + (size_t)u.pn * M * 64 + wc * 32 + 8 * fq;
#pragma unroll
            for (int ai = 0; ai < 2; ++ai)
#pragma unroll
                for (int m = 0; m < 4; ++m) { float* p = P + (size_t)(u.pm * BM + ai * HALF + wr * 64 + m * 16 + fr) * 64; *(f32x4*)p = acc[ai][0][m][0]; *(f32x4*)(p + 4) = acc[ai][0][m][1]; } }
    }
};
struct EpiSwiglu {
    static constexpr bool PERM = true, AFTER_DRAIN = false;
    unsigned o_off; int ldc; unsigned rss_off; float inv_n;
    __device__ __forceinline__ void prefetch(PG8_LAS unsigned char* xl, const Unit& u, int wr, int wid, int lane) const { rss_prefetch(xl, (const u64_t*)(WS_P + rss_off), u, wr, wid, lane); }
    __device__ __forceinline__ void operator()(const f32x4 (&acc)[2][2][4][2], const Unit& u, int wr, int wc, int fr, int fq, const PG8_LAS unsigned char* xl, int wid) const {
        rss_wait();
        unsigned char* ws_ = WS_P; bf16_t* O = (bf16_t*)(ws_ + o_off);
        const int row0 = u.pm * BM + wr * 64 + fr; const int col0 = u.pn * HALF + wc * 32 + 8 * fq;
#pragma unroll
        for (int ai = 0; ai < 2; ++ai)
#pragma unroll
            for (int m = 0; m < 4; ++m) { const int row = row0 + ai * HALF + m * 16; bf16_t* rowp = O + (size_t)row * ldc + col0;
                const float rs = row_rstd(rss_read(xl, wid, ai, m, fr), inv_n);
                const float ce = -1.4426950408889634f * rs, rs2 = rs * rs;
                f32x4 g0 = acc[ai][0][m][0], g1 = acc[ai][0][m][1]; const f32x4 u0 = acc[ai][1][m][0], u1 = acc[ai][1][m][1];
                const f32x4 z0 = g0 * ce, z1 = g1 * ce; f32x4 d0, d1;
#pragma unroll
                for (int e = 0; e < 4; ++e) { d0[e] = __builtin_amdgcn_exp2f(z0[e]); d1[e] = __builtin_amdgcn_exp2f(z1[e]); }
                d0 = d0 + 1.0f; d1 = d1 + 1.0f;
#pragma unroll
                for (int e = 0; e < 4; ++e) { d0[e] = __builtin_amdgcn_rcpf(d0[e]); d1[e] = __builtin_amdgcn_rcpf(d1[e]); }
                g0 = (g0 * u0) * (d0 * rs2); g1 = (g1 * u1) * (d1 * rs2);
                u32x4 w; w.x = cvt_pk_bf16(g0[0], g0[1]); w.y = cvt_pk_bf16(g0[2], g0[3]); w.z = cvt_pk_bf16(g1[0], g1[1]); w.w = cvt_pk_bf16(g1[2], g1[3]);
                *(u32x4*)rowp = w; }
    }
};
struct EpiResid {
    static constexpr bool PERM = true, AFTER_DRAIN = false;
    int use_in; float scale; unsigned rss_off;
    __device__ __forceinline__ void prefetch(PG8_LAS unsigned char*, const Unit&, int, int, int) const {}
    __device__ __forceinline__ void operator()(const f32x4 (&acc)[2][2][4][2], const Unit& u, int wr, int wc, int fr, int fq, const PG8_LAS unsigned char*, int) const {
        unsigned char* ws_ = WS_P; const float* xin = IN_F(0); bf16_t* xn = (bf16_t*)(ws_ + WS_XN); u64_t* rss_out = (u64_t*)(ws_ + rss_off); constexpr int ldc = DM;
        const int col0 = u.pn * BM + wc * 32 + 8 * fq;
#pragma unroll
        for (int ai = 0; ai < 2; ++ai)
#pragma unroll
            for (int m = 0; m < 4; ++m) { const int row = u.pm * BM + ai * HALF + wr * 64 + m * 16 + fr; const size_t off = (size_t)row * ldc + col0;
                f32x4 bs[2][2];
                if (use_in) {
#pragma unroll
                    for (int bj = 0; bj < 2; ++bj)
#pragma unroll
                        for (int n = 0; n < 2; ++n) bs[bj][n] = *(const f32x4*)(xin + off + bj * HALF + n * 4);
                } else {
#pragma unroll
                    for (int bj = 0; bj < 2; ++bj) { const u32x4 w = *(const u32x4*)(xn + off + bj * HALF);
                        bs[bj][0] = (f32x4){__uint_as_float(w.x << 16), __uint_as_float(w.x & 0xffff0000u), __uint_as_float(w.y << 16), __uint_as_float(w.y & 0xffff0000u)};
                        bs[bj][1] = (f32x4){__uint_as_float(w.z << 16), __uint_as_float(w.z & 0xffff0000u), __uint_as_float(w.w << 16), __uint_as_float(w.w & 0xffff0000u)}; }
                }
                float s2 = 0.f;
#pragma unroll
                for (int bj = 0; bj < 2; ++bj) { const f32x4 v0 = bs[bj][0] + acc[ai][bj][m][0] * scale, v1 = bs[bj][1] + acc[ai][bj][m][1] * scale;
                    u32x4 w; w.x = cvt_pk_bf16(v0[0], v0[1]); w.y = cvt_pk_bf16(v0[2], v0[3]); w.z = cvt_pk_bf16(v1[0], v1[1]); w.w = cvt_pk_bf16(v1[2], v1[3]);
                    *(u32x4*)(xn + off + bj * HALF) = w;
                    { const f32x4 t2 = v0 * v0 + v1 * v1; s2 += (t2[0] + t2[1]) + (t2[2] + t2[3]); } }
                s2 = xrow_sum(s2);
                if (fq == 0) stat_add(rss_out + row, s2);
                if (m == 3) asm volatile("" ::: "memory"); }
    }
};
template <class Epi, class Sched, bool ALIGN_EPI = false, bool SP2 = false>
__device__ __forceinline__ void gemm_phase(PG8_LAS unsigned char* lds, const Gemm g, const Sched& S, const Epi& E) {
    int tid_ = threadIdx.x; asm volatile("" : "+v"(tid_));
    const int tid = tid_, wid = __builtin_amdgcn_readfirstlane(tid >> 6), lane = tid & 63, wr = wid >> 2, wc = wid & 3, fr = lane & 15, fq = lane >> 4;
    const int K = g.K, nt = K / BK;
    unsigned voffA[2], voffB[2];
#pragma unroll
    for (int i = 0; i < 2; ++i) { int R, C; stage_rc(tid * 16 + i * 8192, R, C); const int Rb = Epi::PERM ? ((R & ~31) + perm32(R & 31)) : R;
        voffA[i] = (unsigned)(R * g.lda + C) * 2u; voffB[i] = (unsigned)(Rb * (g.ldb ? g.ldb : K) + C) * 2u; }
    const size_t kstep = (size_t)(BK * 2);
    const size_t hstep = (size_t)HALF * (g.ldb ? g.ldb : K) * 2;
    const size_t tstep = 2 * hstep;
    const size_t hstepA = (size_t)HALF * g.lda * 2, tstepA = 2 * hstepA; const size_t bstep = g.b_pn_step ? (size_t)g.b_pn_step : tstep, astep = (size_t)g.a_pn_step;
    const unsigned ldsw = (unsigned)wid * 1024u;
    const int aoff = lds_byte(wr * 64 + fr, fq * 8), boff = lds_byte(wc * 32 + fr, fq * 8);
#define PG8_SA(b, h) (((b) * 2 + (h)) * HTB)
#define PG8_SB(b, h) ((4 + (b) * 2 + (h)) * HTB)
#define PG8_STAGE(bufoff, gbase, voff) do { _Pragma("unroll") for (int _i = 0; _i < 2; ++_i) \
        __builtin_amdgcn_global_load_lds((const unsigned*)((const char*)(gbase) + (voff)[_i]), (PG8_LAS unsigned*)(lds + (bufoff) + ldsw + _i * 8192), 16, 0, 0); } while (0)
#define PG8_LDA(dst, b, h) do { _Pragma("unroll") for (int m = 0; m < 4; ++m) _Pragma("unroll") for (int k = 0; k < 2; ++k) dst[m][k] = *(const PG8_LAS bf16x8*)(lds + PG8_SA(b, h) + aoff + m * 2048 + k * 1024); } while (0)
#define PG8_LDB(dst, b, h) do { _Pragma("unroll") for (int n = 0; n < 2; ++n) _Pragma("unroll") for (int k = 0; k < 2; ++k) dst[n][k] = *(const PG8_LAS bf16x8*)(lds + PG8_SB(b, h) + boff + n * 2048 + k * 1024); } while (0)
#define PG8_MMA(ai, bj, At, Bt) do { __builtin_amdgcn_s_setprio(1); _Pragma("unroll") for (int m = 0; m < 4; ++m) _Pragma("unroll") for (int n = 0; n < 2; ++n) _Pragma("unroll") for (int k = 0; k < 2; ++k) \
        acc[ai][bj][m][n] = __builtin_amdgcn_mfma_f32_16x16x32_bf16(Bt[n][k], At[m][k], acc[ai][bj][m][n], 0, 0, 0); __builtin_amdgcn_s_setprio(0); } while (0)
#define PG8_WAIT_V(n) asm volatile("s_waitcnt vmcnt(" #n ")" ::: "memory")
#define PG8_WAIT_L(n) asm volatile("s_waitcnt lgkmcnt(" #n ")" ::: "memory")
#define PG8_BAR __builtin_amdgcn_s_barrier()
#define PG8_SCHED __builtin_amdgcn_sched_barrier(0)
    Unit cur, nxt; int ui = 0;
    if (!S.next(0, cur)) return;
    f32x4 acc[2][2][4][2];
#pragma unroll
    for (int a = 0; a < 2; ++a)
#pragma unroll
        for (int b = 0; b < 2; ++b)
#pragma unroll
            for (int m = 0; m < 4; ++m)
#pragma unroll
                for (int n = 0; n < 2; ++n) acc[a][b][m][n] = (f32x4){0.f, 0.f, 0.f, 0.f};
    bf16x8 At[4][2], B0[2][2], B1[2][2];
    const char* cA = (const char*)g.A + (size_t)cur.pm * tstepA + (size_t)cur.pn * astep; const char* cB = (const char*)g.Bt + (size_t)cur.pn * bstep;
    S.a_ready(cur);
    if constexpr (SP2) {
        PG8_STAGE(PG8_SB(0, 0), cB, voffB); PG8_STAGE(PG8_SB(0, 1), cB + hstep, voffB); PG8_STAGE(PG8_SA(0, 0), cA, voffA); PG8_STAGE(PG8_SA(0, 1), cA + hstepA, voffA);
        if (wr == 1) PG8_BAR;
        PG8_WAIT_V(2); PG8_BAR;
        PG8_STAGE(PG8_SB(1, 0), cB + kstep, voffB); PG8_STAGE(PG8_SA(1, 0), cA + kstep, voffA); PG8_STAGE(PG8_SB(1, 1), cB + hstep + kstep, voffB);
        PG8_WAIT_V(6); PG8_BAR;
    } else {
        PG8_STAGE(PG8_SB(0, 0), cB, voffB); PG8_STAGE(PG8_SA(0, 0), cA, voffA); PG8_STAGE(PG8_SB(0, 1), cB + hstep, voffB); PG8_STAGE(PG8_SA(0, 1), cA + hstepA, voffA);
        if (wr == 1) PG8_BAR;
        PG8_WAIT_V(4); PG8_BAR;
        PG8_STAGE(PG8_SB(1, 0), cB + kstep, voffB); PG8_STAGE(PG8_SA(1, 0), cA + kstep, voffA); PG8_STAGE(PG8_SB(1, 1), cB + hstep + kstep, voffB);
        PG8_WAIT_V(6); PG8_BAR;
    }
    for (;;) {
        const bool has_next = S.next(ui + 1, nxt);
        const char* nA = has_next ? (const char*)g.A + (size_t)nxt.pm * tstepA + (size_t)nxt.pn * astep : cA; const char* nB = has_next ? (const char*)g.Bt + (size_t)nxt.pn * bstep : cB;
        for (int t = 0; t < nt; t += 2) {
            const bool last = (t == nt - 2);
            const char* a1 = cA + (size_t)(t + 1) * kstep;
            const char* a2 = last ? nA : cA + (size_t)(t + 2) * kstep; const char* b2 = last ? nB : cB + (size_t)(t + 2) * kstep;
            const char* a3 = a2 + kstep; const char* b3 = b2 + kstep;
            if (last && has_next) S.a_ready(nxt);
            if (last) E.prefetch(lds + STAGE_BYTES, cur, wr, wid, lane);
            if constexpr (SP2) {
            PG8_LDB(B0, 0, 0); PG8_LDB(B1, 0, 1); PG8_SCHED; PG8_LDA(At, 0, 0); PG8_STAGE(PG8_SA(1, 1), a1 + hstepA, voffA);
            PG8_WAIT_V(8); PG8_WAIT_L(0); PG8_BAR; PG8_MMA(0, 0, At, B0); PG8_MMA(0, 1, At, B1); PG8_BAR; PG8_SCHED;
            PG8_LDA(At, 0, 1); PG8_STAGE(PG8_SB(0, 0), b2, voffB); PG8_STAGE(PG8_SB(0, 1), b2 + hstep, voffB); PG8_STAGE(PG8_SA(0, 0), a2, voffA);
            PG8_WAIT_V(8); PG8_WAIT_L(0); PG8_BAR; PG8_MMA(1, 0, At, B0); PG8_MMA(1, 1, At, B1); PG8_BAR; PG8_SCHED;
            PG8_LDB(B0, 1, 0); PG8_LDB(B1, 1, 1); PG8_SCHED; PG8_LDA(At, 1, 0); PG8_STAGE(PG8_SA(0, 1), a2 + hstepA, voffA);
            PG8_WAIT_V(8); PG8_WAIT_L(0); PG8_BAR; PG8_MMA(0, 0, At, B0); PG8_MMA(0, 1, At, B1); PG8_BAR; PG8_SCHED;
            PG8_LDA(At, 1, 1); PG8_STAGE(PG8_SB(1, 0), b3, voffB); PG8_STAGE(PG8_SB(1, 1), b3 + hstep, voffB); PG8_STAGE(PG8_SA(1, 0), a3, voffA);
            PG8_WAIT_V(8); PG8_WAIT_L(0); PG8_BAR; PG8_MMA(1, 0, At, B0); PG8_MMA(1, 1, At, B1); PG8_BAR; PG8_SCHED;
            } else {
            PG8_LDB(B0, 0, 0); PG8_SCHED; PG8_LDA(At, 0, 0); PG8_STAGE(PG8_SA(1, 1), a1 + hstepA, voffA);
            PG8_WAIT_L(8); PG8_BAR; PG8_WAIT_L(0); PG8_MMA(0, 0, At, B0); PG8_BAR; PG8_SCHED;
            PG8_LDB(B1, 0, 1); PG8_STAGE(PG8_SB(0, 0), b2, voffB);
            PG8_BAR; PG8_WAIT_L(0); PG8_MMA(0, 1, At, B1); PG8_BAR;
            PG8_LDA(At, 0, 1); PG8_STAGE(PG8_SA(0, 0), a2, voffA);
            PG8_BAR; PG8_WAIT_L(0); PG8_MMA(1, 0, At, B0); PG8_BAR; PG8_SCHED;
            PG8_STAGE(PG8_SB(0, 1), b2 + hstep, voffB);
            PG8_WAIT_V(6); PG8_BAR; PG8_MMA(1, 1, At, B1); PG8_BAR;
            PG8_LDB(B0, 1, 0); PG8_SCHED; PG8_LDA(At, 1, 0); PG8_STAGE(PG8_SA(0, 1), a2 + hstepA, voffA);
            PG8_WAIT_L(8); PG8_BAR; PG8_WAIT_L(0); PG8_MMA(0, 0, At, B0); PG8_BAR; PG8_SCHED;
            PG8_LDB(B1, 1, 1); PG8_STAGE(PG8_SB(1, 0), b3, voffB);
            PG8_BAR; PG8_WAIT_L(0); PG8_MMA(0, 1, At, B1); PG8_BAR;
            PG8_LDA(At, 1, 1); PG8_STAGE(PG8_SA(1, 0), a3, voffA);
            PG8_BAR; PG8_WAIT_L(0); PG8_MMA(1, 0, At, B0); PG8_BAR; PG8_SCHED;
            PG8_STAGE(PG8_SB(1, 1), b3 + hstep, voffB);
            PG8_WAIT_V(6); PG8_BAR; PG8_MMA(1, 1, At, B1); PG8_BAR;
            }
        }
        if constexpr (ALIGN_EPI) { if (wr == 0) PG8_BAR; }
        if constexpr (!Epi::AFTER_DRAIN) { E(acc, cur, wr, wc, fr, fq, lds + STAGE_BYTES, wid); S.done(cur); }
        if (!has_next) break;
#pragma unroll
        for (int a = 0; a < 2; ++a)
#pragma unroll
            for (int b = 0; b < 2; ++b)
#pragma unroll
                for (int m = 0; m < 4; ++m)
#pragma unroll
                    for (int n = 0; n < 2; ++n) acc[a][b][m][n] = (f32x4){0.f, 0.f, 0.f, 0.f};
        cur = nxt; cA = nA; cB = nB; ++ui;
        if constexpr (ALIGN_EPI) { if (wr == 1) PG8_BAR; }
    }
    PG8_WAIT_V(0);
    if constexpr (!ALIGN_EPI) { if (wr == 0) PG8_BAR; }
    PG8_BAR;
    if constexpr (Epi::AFTER_DRAIN) { E.fused(acc, cur, wr, wc, fr, fq, lds, wid, lane); S.done(cur); }
#undef PG8_SA
#undef PG8_SB
#undef PG8_STAGE
#undef PG8_LDA
#undef PG8_LDB
#undef PG8_MMA
#undef PG8_WAIT_V
#undef PG8_WAIT_L
#undef PG8_BAR
#undef PG8_SCHED
}
}

#ifndef MK_PER_PHASE
#define MK_PER_PHASE 0
#endif
#define LAS __attribute__((address_space(3)))
typedef unsigned short bf16;
typedef unsigned v4u __attribute__((ext_vector_type(4)));
typedef unsigned v2u __attribute__((ext_vector_type(2)));
typedef float f32x4 __attribute__((ext_vector_type(4)));
typedef float f32x2v __attribute__((ext_vector_type(2)));
typedef short bf16x8 __attribute__((ext_vector_type(8)));
typedef short s16x4 __attribute__((ext_vector_type(4)));
typedef float f32x16 __attribute__((ext_vector_type(16)));

__device__ __forceinline__ float wave_sum(float v) {
#pragma unroll
    for (int o = 1; o < 64; o <<= 1) v += __shfl_xor(v, o);
    return v;
}
__device__ __forceinline__ unsigned pk2(float lo, float hi) { return pg8::cvt_pk_bf16(lo, hi); }
__device__ __forceinline__ float bflo(unsigned w) { return __uint_as_float(w << 16); }
__device__ __forceinline__ float bfhi(unsigned w) { return __uint_as_float(w & 0xffff0000u); }

__device__ __forceinline__ void transpose_item(const float* W, int K, int N, bf16* WT, int mode, float scale, const float* kgain, LAS float* scr, int item, int lane) {
    const int nblk = N / 64, kb = item / nblk, nb = item % nblk, k0 = 64 * kb, n0 = 64 * nb;
    int drow0 = n0;
    if (mode == 1) { const int half = (n0 >= FF) ? 1 : 0; const int j = n0 - half * FF; drow0 = (j >> 7) * 256 + half * 128 + (j & 127); }
    f32x2v v[32];
    const float* src = W + (size_t)(k0 + (lane >> 5)) * N + n0 + 2 * (lane & 31);
#pragma unroll
    for (int i = 0; i < 32; ++i) v[i] = __builtin_nontemporal_load((const f32x2v*)(src + (size_t)(2 * i) * N));
#pragma unroll
    for (int i = 0; i < 32; ++i) { LAS float* d = scr + (2 * i + (lane >> 5)) * 65 + 2 * (lane & 31); d[0] = v[i].x; d[1] = v[i].y; }
    asm volatile("s_waitcnt lgkmcnt(0)" ::: "memory");
    const int c = lane & 7;
    f32x4 g0 = (f32x4){scale, scale, scale, scale}, g1 = g0;
    if (kgain) { g0 = *(const f32x4*)(kgain + k0 + 8 * c) * scale; g1 = *(const f32x4*)(kgain + k0 + 8 * c + 4) * scale; }
#pragma unroll
    for (int j = 0; j < 8; ++j) { const int n = (lane >> 3) + 8 * j; const LAS float* s = scr + (8 * c) * 65 + n;
        v4u o; o.x = pk2(s[0 * 65] * g0.x, s[1 * 65] * g0.y); o.y = pk2(s[2 * 65] * g0.z, s[3 * 65] * g0.w); o.z = pk2(s[4 * 65] * g1.x, s[5 * 65] * g1.y); o.w = pk2(s[6 * 65] * g1.z, s[7 * 65] * g1.w);
        *(v4u*)(WT + (size_t)(drow0 + n) * K + k0 + 8 * c) = o; }
    asm volatile("s_waitcnt lgkmcnt(0)" ::: "memory");
}
__device__ __forceinline__ void transpose_matrix(const float* W, int K, int N, bf16* WT, int mode, float scale, const float* kgain, LAS float* scr, int gw, int NGW, int lane) {
    const int items = (K / 64) * (N / 64);
    for (int it = gw; it < items; it += NGW) transpose_item(W, K, N, WT, mode, scale, kgain, scr, it, lane);
}

__device__ __forceinline__ void row_bf16_ss(const float* xrow, bf16* orow, u64_t* ss_out, int lane) {
    const f32x4* xr = (const f32x4*)xrow + lane;
    f32x4 v[8]; float s = 0.f;
#pragma unroll
    for (int j = 0; j < 8; ++j) { v[j] = xr[64 * j]; s += (v[j].x * v[j].x + v[j].y * v[j].y) + (v[j].z * v[j].z + v[j].w * v[j].w); }
    s = wave_sum(s);
    v2u* o8 = (v2u*)orow + lane;
#pragma unroll
    for (int j = 0; j < 8; ++j) { v2u o; o.x = pk2(v[j].x, v[j].y); o.y = pk2(v[j].z, v[j].w); o8[64 * j] = o; }
    if (lane == 0) *ss_out = (u64_t)__float2ll_rn(s * 16777216.0f);
}
__device__ __forceinline__ void rms_row_out(const bf16* xrow, const float* g, float ss, float* orow, int lane) {
    const float rstd = 1.0f / sqrtf(ss * (1.f / DM) + EPS);
    const v4u* xr = (const v4u*)xrow + lane; const f32x4* gr = (const f32x4*)g + 2 * lane; f32x4* o = (f32x4*)orow + 2 * lane;
    v4u w[4];
#pragma unroll
    for (int j = 0; j < 4; ++j) w[j] = xr[64 * j];
#pragma unroll
    for (int j = 0; j < 4; ++j) { const f32x4 g0 = gr[128 * j], g1 = gr[128 * j + 1];
        o[128 * j] = (f32x4){bflo(w[j].x) * rstd * g0.x, bfhi(w[j].x) * rstd * g0.y, bflo(w[j].y) * rstd * g0.z, bfhi(w[j].y) * rstd * g0.w};
        o[128 * j + 1] = (f32x4){bflo(w[j].z) * rstd * g1.x, bfhi(w[j].z) * rstd * g1.y, bflo(w[j].w) * rstd * g1.z, bfhi(w[j].w) * rstd * g1.w}; }
}

__device__ __forceinline__ void sgu_spatial_phase(LAS unsigned char* lds, const bf16* U, bf16* GO, const bf16* V, const u64_t* vsum, const u64_t* vsq, const float* gain, const float* bias, const float* wsp, const float* bsp, int G, int bx) {
    constexpr int P = 272, VTB = 128 * P;
    LAS unsigned char* WsL = lds; LAS float* GB = (LAS float*)(lds + 3 * VTB);
    int tid_ = threadIdx.x; asm volatile("" : "+v"(tid_));
    const int tid = tid_, lane = tid & 63, fr = lane & 15, fq = lane >> 4; const int wid = __builtin_amdgcn_readfirstlane(tid >> 6);
    const int cc = tid & 15, jp = tid >> 4;
    const bool grp_ = (G & 7) == 0; const int gx_ = bx & 7, slot_ = bx >> 3, nslot_ = G >> 3;
    const int nunits = grp_ ? (slot_ < 128 ? (128 - slot_ + nslot_ - 1) / nslot_ : 0) : (bx < 1024 ? (1024 - bx + G - 1) / G : 0), nch = 4 * nunits;
    const int i0 = wid * 16; const int nks = (i0 < 64) ? 2 : 4;
    v4u vr[2][4], ur[2][4]; f32x2v sr[2][4];
    int cur_g = -1; float bsv = 0.f;
#define SP_COORD(t) const int u_ = grp_ ? slot_ + ((t) >> 2) * nslot_ : bx + ((t) >> 2) * G, g_ = u_ & 7, nb_ = grp_ ? 16 * gx_ + (u_ >> 3) : (u_ >> 3), chunk_ = (t) & 3; const size_t row0_ = (size_t)nb_ * 128; const int cbase_ = g_ * 512 + chunk_ * 128;
#define SP_LOAD(slot, t) do { SP_COORD(t) \
        _Pragma("unroll") for (int hs_ = 0; hs_ < 4; ++hs_) { const size_t r_ = row0_ + 64 * (hs_ >> 1) + 2 * jp + (hs_ & 1); vr[slot][hs_] = *(const v4u*)(V + r_ * SW + cbase_ + cc * 8); { const float mu_ = stat_get(vsum[r_]) * (1.f / SW); sr[slot][hs_] = (f32x2v){mu_, 1.0f / sqrtf(fmaxf(stat_get(vsq[r_]) * (1.f / SW) - mu_ * mu_, 0.f) + EPS)}; } } \
        _Pragma("unroll") for (int c4_ = 0; c4_ < 4; ++c4_) ur[slot][c4_] = *(const v4u*)(U + (row0_ + i0 + fr) * SW + cbase_ + c4_ * 32 + 8 * fq); } while (0)
#define SP_STEP(slot, t, buf) do { SP_COORD(t) \
        if (chunk_ == 0 && g_ != cur_g) { __syncthreads(); \
            _Pragma("unroll") for (int i_ = 0; i_ < 8; ++i_) { const int e4 = tid + 512 * i_; f32x4 w = *(const f32x4*)(wsp + (size_t)g_ * 16384 + (size_t)e4 * 4); const int row = e4 >> 5, j = (e4 & 31) * 4; \
                if ((row >> 6) < (j >> 6)) w = (f32x4){0.f, 0.f, 0.f, 0.f}; \
                *(LAS v2u*)(WsL + row * P + j * 2) = (v2u){pk2(w.x, w.y), pk2(w.z, w.w)}; } \
            GB[tid] = gain[g_ * 512 + tid]; GB[512 + tid] = bias[g_ * 512 + tid]; bsv = bsp[g_ * 128 + i0 + fr]; cur_g = g_; __syncthreads(); } \
        LAS unsigned char* VTb = lds + (1 + (buf)) * VTB; \
        { const int lc = chunk_ * 128 + cc * 8; \
          const f32x4 ga0 = *(const LAS f32x4*)(GB + lc), ga1 = *(const LAS f32x4*)(GB + lc + 4), bi0 = *(const LAS f32x4*)(GB + 512 + lc), bi1 = *(const LAS f32x4*)(GB + 512 + lc + 4); \
          _Pragma("unroll") for (int half = 0; half < 2; ++half) { const int j = 64 * half + 2 * jp; const v4u w0 = vr[slot][2 * half], w1 = vr[slot][2 * half + 1]; const f32x2v s0 = sr[slot][2 * half], s1 = sr[slot][2 * half + 1]; \
              const int cofs = (((j >> 3) ^ cc) << 4) + (j & 7) * 2; \
              _Pragma("unroll") for (int e = 0; e < 4; ++e) { const float gA = e < 2 ? ga0[2 * e] : ga1[2 * e - 4], gB = e < 2 ? ga0[2 * e + 1] : ga1[2 * e - 3], bA = e < 2 ? bi0[2 * e] : bi1[2 * e - 4], bB = e < 2 ? bi0[2 * e + 1] : bi1[2 * e - 3]; \
                  const float y0a = (bflo(w0[e]) - s0.x) * s0.y * gA + bA, y1a = (bflo(w1[e]) - s1.x) * s1.y * gA + bA; \
                  const float y0b = (bfhi(w0[e]) - s0.x) * s0.y * gB + bB, y1b = (bfhi(w1[e]) - s1.x) * s1.y * gB + bB; \
                  *(LAS unsigned*)(VTb + (cc * 8 + 2 * e) * P + cofs) = pk2(y0a, y1a); \
                  *(LAS unsigned*)(VTb + (cc * 8 + 2 * e + 1) * P + cofs) = pk2(y0b, y1b); } } } \
        __syncthreads(); \
        bf16x8 wf[4]; \
        _Pragma("unroll") for (int ks = 0; ks < 4; ++ks) wf[ks] = *(const LAS bf16x8*)(WsL + (i0 + fr) * P + (32 * ks + 8 * fq) * 2); \
        _Pragma("unroll") for (int c4 = 0; c4 < 4; ++c4) { \
            f32x4 acc[2]; \
            _Pragma("unroll") for (int n = 0; n < 2; ++n) { acc[n] = (f32x4){0.f, 0.f, 0.f, 0.f}; const int vrow = c4 * 32 + 8 * (fr >> 2) + 4 * n + (fr & 3); const int sw = (vrow >> 3) & 15; \
                _Pragma("unroll") for (int ks = 0; ks < 4; ++ks) if (ks < nks) { const bf16x8 vf = *(const LAS bf16x8*)(VTb + vrow * P + (((4 * ks + fq) ^ sw) << 4)); acc[n] = __builtin_amdgcn_mfma_f32_16x16x32_bf16(vf, wf[ks], acc[n], 0, 0, 0); } } \
            bf16* up = GO + (row0_ + i0 + fr) * SW + cbase_ + c4 * 32 + 8 * fq; \
            const v4u uw = ur[slot][c4]; v4u o; \
            o.x = pk2(bflo(uw.x) * (acc[0][0] + bsv), bfhi(uw.x) * (acc[0][1] + bsv)); o.y = pk2(bflo(uw.y) * (acc[0][2] + bsv), bfhi(uw.y) * (acc[0][3] + bsv)); \
            o.z = pk2(bflo(uw.z) * (acc[1][0] + bsv), bfhi(uw.z) * (acc[1][1] + bsv)); o.w = pk2(bflo(uw.w) * (acc[1][2] + bsv), bfhi(uw.w) * (acc[1][3] + bsv)); \
            *(v4u*)up = o; } \
        if ((t) + 2 < nch) SP_LOAD(slot, (t) + 2); } while (0)
    if (nch > 0) { SP_LOAD(0, 0); SP_LOAD(1, 1); }
    for (int t = 0; t < nch; t += 2) { SP_STEP(0, t, 0); SP_STEP(1, t + 1, 1); }
    __syncthreads();
#undef SP_COORD
#undef SP_LOAD
#undef SP_STEP
}

__device__ __forceinline__ int crow(int r, int hi) { return (r & 3) + 8 * (r >> 2) + 4 * hi; }
__device__ __forceinline__ float att_max3(float a, float b, float c) { float r; asm("v_max3_f32 %0, %1, %2, %3" : "=v"(r) : "v"(a), "v"(b), "v"(c)); return r; }
__device__ __forceinline__ float att_max2(float a, float b) { float r; asm("v_max_f32_e32 %0, %1, %2" : "=v"(r) : "v"(a), "v"(b)); return r; }
__device__ __forceinline__ void attn_unit(int b, int h, int qb, const bf16* Q, const bf16* KV, const bf16* KR, const f32x2v* tab, bf16* O, LAS unsigned char* lds) {
    constexpr int KP = 400, KBUF = 64 * KP, VBUF = 16384, VOFF = 2 * KBUF, WSF_OFF = VOFF + 3 * VBUF;
    int tid_ = threadIdx.x; asm volatile("" : "+v"(tid_));
    const int tid = tid_, lane = tid & 63, r32 = lane & 31, hi = lane >> 5; const int wid = __builtin_amdgcn_readfirstlane(tid >> 6);
    const size_t rowbase = (size_t)b * SEQ; const int q0 = qb * 256;
    const int NT = 4 * qb + 4, my_last = 4 * qb + (wid >> 1);
    LAS float* wsf = (LAS float*)(lds + WSF_OFF) + wid * 64;
    const bf16* ksrc[4]; const bf16* vsrc[2]; long kstep[4];
#pragma unroll
    for (int j = 0; j < 4; ++j) { const int off = (wid + 8 * j) * 1024 + lane * 16, row = (off / KP) & 63; int c = (off % KP) >> 4; if (c >= 24) c = 0;
        if (c < 16) { ksrc[j] = KV + (rowbase + row) * KVUP_N + h * 256 + c * 8; kstep[j] = 64L * KVUP_N; } else { ksrc[j] = KR + (rowbase + row) * 64 + (c - 16) * 8; kstep[j] = 64L * 64; } }
#pragma unroll
    for (int j = 0; j < 2; ++j) { const int off = (wid + 8 * j) * 1024 + lane * 16, cblk = off >> 12, rem = off & 4095, kv = (rem >> 9) * 8 + ((rem & 511) >> 6), d = cblk * 32 + ((rem & 63) >> 4) * 8;
        vsrc[j] = KV + (rowbase + kv) * KVUP_N + h * 256 + 128 + d; }
#define ATT_DMA(kt, kb, vb) do { \
        _Pragma("unroll") for (int j_ = 0; j_ < 3; ++j_) __builtin_amdgcn_global_load_lds((const unsigned*)(ksrc[j_] + (long)(kt) * kstep[j_]), (LAS unsigned*)(lds + (kb) * KBUF + (wid + 8 * j_) * 1024), 16, 0, 0); \
        if (wid == 0) __builtin_amdgcn_global_load_lds((const unsigned*)(ksrc[3] + (long)(kt) * kstep[3]), (LAS unsigned*)(lds + (kb) * KBUF + 24 * 1024), 16, 0, 0); \
        _Pragma("unroll") for (int j_ = 0; j_ < 2; ++j_) __builtin_amdgcn_global_load_lds((const unsigned*)(vsrc[j_] + (long)(kt) * 64L * KVUP_N), (LAS unsigned*)(lds + VOFF + (vb) * VBUF + (wid + 8 * j_) * 1024), 16, 0, 0); } while (0)
    ATT_DMA(0, 0, 0);
    const size_t qrow = rowbase + q0 + wid * 32 + r32;
    const bf16* Qp = Q + qrow * QUP_N + h * QKD + hi * 8;
    v4u qr[12];
#pragma unroll
    for (int d0 = 0; d0 < 12; ++d0) qr[d0] = *(const v4u*)(Qp + d0 * 16);
#pragma unroll
    for (int dd = 0; dd < 2; ++dd) { const f32x4* cs = (const f32x4*)(tab + qrow * 32 + 16 * dd + 8 * hi);
#pragma unroll
        for (int jj = 0; jj < 4; ++jj) { const f32x4 t = cs[jj]; const unsigned a = qr[8 + dd][jj], c = qr[10 + dd][jj];
            const float x1l = bflo(a), x1h = bfhi(a), x2l = bflo(c), x2h = bfhi(c);
            qr[8 + dd][jj] = pk2(x1l * t.x - x2l * t.y, x1h * t.z - x2h * t.w);
            qr[10 + dd][jj] = pk2(x1l * t.y + x2l * t.x, x1h * t.w + x2h * t.z); } }
    float mhat = 0.f, lsum = 0.f; f32x16 o[4];
#pragma unroll
    for (int c = 0; c < 4; ++c)
#pragma unroll
        for (int r = 0; r < 16; ++r) o[c][r] = 0.f;
    asm volatile("s_waitcnt vmcnt(0)" ::: "memory");
    __syncthreads();
    v4u pw[4];
#pragma unroll
    for (int i = 0; i < 4; ++i) pw[i] = (v4u){0u, 0u, 0u, 0u};
    int vprev = 0, vcur = 0, vnext = 1;
    const int vlane = (4 * hi + ((lane & 15) >> 2)) * 64 + ((lane >> 4) & 1) * 32 + (lane & 3) * 8;
#define TRD(p) __builtin_bit_cast(s16x4, __builtin_amdgcn_ds_read_tr16_b64_v4i16((LAS s16x4*)(p)))
#define ATT_VRD(i, dst) do { const LAS unsigned char* q_ = vp + ((i) >> 1) * 4096 + (2 * ((i) & 1)) * 1024; dst[0] = TRD(q_); dst[1] = TRD(q_ + 512); dst[2] = TRD(q_ + 1024); dst[3] = TRD(q_ + 1536); } while (0)
#define ATT_CAT(a, b) ((bf16x8){a[0], a[1], a[2], a[3], b[0], b[1], b[2], b[3]})
#define ATT_PVM(i, src) do { o[(i) >> 1] = __builtin_amdgcn_mfma_f32_32x32x16_bf16(__builtin_bit_cast(bf16x8, pw[2 * ((i) & 1)]), ATT_CAT(src[0], src[1]), o[(i) >> 1], 0, 0, 0); \
                              o[(i) >> 1] = __builtin_amdgcn_mfma_f32_32x32x16_bf16(__builtin_bit_cast(bf16x8, pw[2 * ((i) & 1) + 1]), ATT_CAT(src[2], src[3]), o[(i) >> 1], 0, 0, 0); } while (0)
#define ATT_SMC(i) do { if ((i) < 4) { _Pragma("unroll") for (int r = 4 * (i); r < 4 * (i) + 4; ++r) { p0[r] = __builtin_amdgcn_exp2f(p0[r]); sacc += p0[r]; } \
                                      if ((i) & 1) { const int k_ = (i) >> 1; _Pragma("unroll") for (int w = 0; w < 4; ++w) pn[k_][w] = pk2(p0[8 * k_ + 2 * w], p0[8 * k_ + 2 * w + 1]); } } \
                        else { _Pragma("unroll") for (int r = 4 * ((i) - 4); r < 4 * ((i) - 4) + 4; ++r) { p1[r] = __builtin_amdgcn_exp2f(p1[r]); sacc += p1[r]; } \
                               if ((i) & 1) { const int k_ = ((i) - 4) >> 1; _Pragma("unroll") for (int w = 0; w < 4; ++w) pn[2 + k_][w] = pk2(p1[8 * k_ + 2 * w], p1[8 * k_ + 2 * w + 1]); } } } while (0)
#define ATT_MIX(DO_PV, DO_SM) do { const LAS unsigned char* vp = lds + VOFF + vprev * VBUF + vlane; s16x4 va[4], vb[4]; float sacc = 0.f; \
        if (DO_PV) ATT_VRD(0, va); \
        _Pragma("unroll") for (int i = 0; i < 8; ++i) { \
            if (DO_PV && i + 1 < 8) { if (i & 1) ATT_VRD(i + 1, va); else ATT_VRD(i + 1, vb); } \
            __builtin_amdgcn_sched_barrier(0); \
            if (DO_PV) { if (i & 1) ATT_PVM(i, vb); else ATT_PVM(i, va); } \
            if (DO_SM) ATT_SMC(i); \
            __builtin_amdgcn_sched_barrier(0); } \
        if (DO_SM) lsum += sacc; } while (0)
    for (int t = 0; t < NT; ++t) {
        if (t + 1 < NT) ATT_DMA(t + 1, (t + 1) & 1, vnext);
        const bool do_qk = (t <= my_last);
        f32x16 p0, p1; bool resc = false; v4u pn[4];
        if (do_qk) {
            const LAS unsigned char* Kb = lds + (t & 1) * KBUF + r32 * KP; const int ksw = r32 & 7;
            { const float nm = -mhat;
#pragma unroll
              for (int r = 0; r < 16; ++r) { p0[r] = nm; p1[r] = nm; } }
            bf16x8 kf[6][4];
#define KOF(d0) ((2 * (d0) + hi) * 16)
#define KLD(g) do { kf[g][0] = *(const LAS bf16x8*)(Kb + KOF(2 * (g))); kf[g][1] = *(const LAS bf16x8*)(Kb + 32 * KP + KOF(2 * (g))); \
                    kf[g][2] = *(const LAS bf16x8*)(Kb + KOF(2 * (g) + 1)); kf[g][3] = *(const LAS bf16x8*)(Kb + 32 * KP + KOF(2 * (g) + 1)); } while (0)
            KLD(0);
#pragma unroll
            for (int g = 0; g < 6; ++g) {
                if (g + 1 < 6) KLD(g + 1);
                __builtin_amdgcn_sched_barrier(0);
                const bf16x8 qa = __builtin_bit_cast(bf16x8, qr[2 * g]), qb_ = __builtin_bit_cast(bf16x8, qr[2 * g + 1]);
                p0 = __builtin_amdgcn_mfma_f32_32x32x16_bf16(kf[g][0], qa, p0, 0, 0, 0); p1 = __builtin_amdgcn_mfma_f32_32x32x16_bf16(kf[g][1], qa, p1, 0, 0, 0);
                p0 = __builtin_amdgcn_mfma_f32_32x32x16_bf16(kf[g][2], qb_, p0, 0, 0, 0); p1 = __builtin_amdgcn_mfma_f32_32x32x16_bf16(kf[g][3], qb_, p1, 0, 0, 0);
                __builtin_amdgcn_sched_barrier(0);
            }
#undef KLD
#undef KOF
            asm volatile("s_nop 15\n\ts_nop 7" : "+v"(p0), "+v"(p1));
            float rm;
            { float a = att_max3(p0[0], p0[1], p1[0]), b = att_max3(p0[2], p0[3], p1[1]); a = att_max3(a, p1[2], p1[3]);
#pragma unroll
              for (int r = 4; r < 16; r += 4) { a = att_max3(a, p0[r], p0[r + 1]); b = att_max3(b, p0[r + 2], p0[r + 3]); a = att_max3(a, p1[r], p1[r + 1]); b = att_max3(b, p1[r + 2], p1[r + 3]); }
              rm = att_max2(a, b); }
            { auto rr = __builtin_amdgcn_permlane32_swap(__float_as_uint(rm), __float_as_uint(rm), false, false); rm = att_max2(__uint_as_float(rr[0]), __uint_as_float(rr[1])); }
            const bool first = (t == 0);
            if (first || __any(rm > 8.0f)) {
                const float dl = first ? rm : fmaxf(rm, 0.f);
                mhat += dl;
#pragma unroll
                for (int r = 0; r < 16; ++r) { p0[r] -= dl; p1[r] -= dl; }
                if (!first) { const float f = __builtin_amdgcn_exp2f(-dl); lsum *= f; if (hi == 0) wsf[r32] = f; resc = true; }
            }
        }
        __builtin_amdgcn_sched_barrier(0);
        if (do_qk) {
            vprev = vcur;
            ATT_MIX(false, true);
            if (resc) {
#pragma unroll
                for (int r = 0; r < 16; ++r) { const float fr_ = wsf[crow(r, hi)];
#pragma unroll
                    for (int c = 0; c < 4; ++c) o[c][r] *= fr_; }
            }
#pragma unroll
            for (int i = 0; i < 4; ++i) pw[i] = pn[i];
            ATT_MIX(true, false);
        }
        asm volatile("s_waitcnt vmcnt(0)" ::: "memory");
        __syncthreads();
        vprev = vcur; vcur = vnext; vnext = (vnext == 2) ? 0 : vnext + 1;
    }
#undef ATT_MIX
#undef ATT_SMC
#undef ATT_PVM
#undef ATT_CAT
#undef ATT_VRD
#undef TRD
    { auto rr = __builtin_amdgcn_permlane32_swap(__float_as_uint(lsum), __float_as_uint(lsum), false, false); lsum = __uint_as_float(rr[0]) + __uint_as_float(rr[1]); }
    if (hi == 0) wsf[32 + r32] = lsum;
    bf16* Ow = O + (rowbase + q0 + wid * 32) * DM + h * 128 + r32;
#pragma unroll
    for (int r = 0; r < 16; ++r) { const int orow = crow(r, hi); const float rl = __builtin_amdgcn_rcpf(wsf[32 + orow]);
#pragma unroll
        for (int c = 0; c < 4; c += 1) { const unsigned w = pk2(o[c][r] * rl, 0.f); Ow[(size_t)orow * DM + 32 * c] = (bf16)(w & 0xffffu); } }
#undef ATT_DMA
}
__device__ __forceinline__ void attn_phase(LAS unsigned char* lds, const bf16* Q, const bf16* KV, const bf16* KR, const f32x2v* tab, bf16* O, int G, int bx) {
    for (int i = 0;; ++i) { const int idx = i * G + bx; if (idx >= 1024) break;
        const int i4 = idx >> 8, v0 = idx & 255, v = (v0 & 7) * 32 + (v0 >> 3), bh = v >> 3, s = v & 7;
        const int qb = i4 == 0 ? 31 - s : i4 == 1 ? 16 + s : i4 == 2 ? 15 - s : s;
        attn_unit(bh >> 4, bh & 15, qb, Q, KV, KR, tab, O, lds); }
}

typedef GAS unsigned gu32;
#define XB_TMO      128
#define XB_XCNT(j)  (256  + 64 * (j))
#define XB_XSUB(j)  (1280 + 64 * (j))
#define XB_XGEN(j)  (2304 + 64 * (j))
#define XB_TOP      3328
#define XB_TOPGEN   3392
#define XCD_BAR_WORDS 3456
#define XB_SPIN_CAP (1u << 18)

__device__ __forceinline__ unsigned xb_ld(unsigned* p)              { return __hip_atomic_load(p, __ATOMIC_RELAXED, __HIP_MEMORY_SCOPE_AGENT); }
__device__ __forceinline__ unsigned xb_add(unsigned* p, unsigned v) { return __hip_atomic_fetch_add(p, v, __ATOMIC_RELAXED, __HIP_MEMORY_SCOPE_AGENT); }
__device__ __forceinline__ unsigned xb_xcc_id() { return (unsigned)__builtin_amdgcn_s_getreg((3 << 11) | 20) & 0xFu; }
#define XB_SPIN(cond, bar) do { unsigned _sp = 0; while (cond) { __builtin_amdgcn_s_sleep(1); \
    if ((++_sp & 255u) == 0u) { if (xb_ld(&(bar)[XB_TMO])) break; if (_sp > XB_SPIN_CAP) { atomicAdd(&(bar)[XB_TMO], 1u); break; } } } } while (0)

struct XcdBarrier {
    unsigned* bar; unsigned x;
    volatile LAS unsigned* st;
};

__device__ __forceinline__ XcdBarrier xcd_barrier_post(unsigned* bar, volatile LAS unsigned* st) {
    XcdBarrier b; b.bar = bar; b.x = xb_xcc_id(); b.st = st;
    if (threadIdx.x == 0) (void)xb_add(&bar[XB_XCNT(b.x)], 1u);
    return b;
}
__device__ __forceinline__ void xcd_barrier_complete(unsigned* bar, unsigned x, unsigned& nloc, unsigned& nx) {
    const unsigned G = gridDim.x * gridDim.y * gridDim.z;
    unsigned sum, cnt, mine, sp = 0u;
    for (;;) {
        sum = 0u; cnt = 0u; mine = 0u;
#pragma unroll
        for (unsigned j = 0; j < 16; ++j) { const unsigned c = xb_ld(&bar[XB_XCNT(j)]); sum += c; cnt += (c > 0u) ? 1u : 0u; mine = (j == x) ? c : mine; }
        if (sum == G) break;
        __builtin_amdgcn_s_sleep(1);
        if ((++sp & 255u) == 0u) { if (xb_ld(&bar[XB_TMO])) break; if (sp > XB_SPIN_CAP) { atomicAdd(&bar[XB_TMO], 1u); break; } }
    }
    nloc = mine > 0u ? mine : 1u; nx = cnt > 0u ? cnt : 1u;
}

__device__ __forceinline__ void xcd_barrier(const XcdBarrier& b) {
    asm volatile("s_waitcnt vmcnt(0)" ::: "memory");
    __syncthreads();
    if (threadIdx.x == 0) {
        unsigned* bar = b.bar;
        __builtin_amdgcn_s_waitcnt(0);
        unsigned nloc = b.st[0], nx = b.st[1];
        if (nloc == 0u) { xcd_barrier_complete(bar, b.x, nloc, nx); b.st[0] = nloc; b.st[1] = nx; }
        const unsigned old = xb_add(&bar[XB_XSUB(b.x)], 1u);
        const unsigned gen = old / nloc;
        if (old + 1u == (gen + 1u) * nloc) {
            __builtin_amdgcn_fence(__ATOMIC_RELEASE, "agent");
            asm volatile("s_waitcnt vmcnt(0)" ::: "memory");
            const unsigned og = xb_add(&bar[XB_TOP], 1u);
            const unsigned tg = og / nx;
            if (og + 1u == (tg + 1u) * nx) xb_add(&bar[XB_TOPGEN], 1u);
            else XB_SPIN(xb_ld(&bar[XB_TOPGEN]) == tg, bar);
            __builtin_amdgcn_fence(__ATOMIC_ACQUIRE, "agent");
            xb_add(&bar[XB_XGEN(b.x)], 1u);
            asm volatile("s_waitcnt vmcnt(0)" ::: "memory");
        } else {
            XB_SPIN(xb_ld(&bar[XB_XGEN(b.x)]) == gen, bar);
            __builtin_amdgcn_fence(__ATOMIC_ACQUIRE, "agent");
            asm volatile("s_waitcnt vmcnt(0)" ::: "memory");
        }
    }
    __syncthreads();
}

#define GRP_BAR_WORD0 3584
__device__ __forceinline__ void grp_barrier(unsigned* words, int grp, unsigned nblk) {
    asm volatile("s_waitcnt vmcnt(0)" ::: "memory");
    __syncthreads();
    if (threadIdx.x == 0) {
        __builtin_amdgcn_fence(__ATOMIC_RELEASE, "agent");
        asm volatile("s_waitcnt vmcnt(0)" ::: "memory");
        unsigned* c = words + GRP_BAR_WORD0 + 64 * grp;
        const unsigned old = xb_add(c, 1u), target = (old / nblk + 1u) * nblk;
        unsigned sp = 0u;
        while (xb_ld(c) < target) { __builtin_amdgcn_s_sleep(1); if (++sp > (1u << 22)) break; }
        __builtin_amdgcn_fence(__ATOMIC_ACQUIRE, "agent");
        asm volatile("s_waitcnt vmcnt(0)" ::: "memory");
    }
    __syncthreads();
}
#ifndef GRP_SEAM_MASK
#define GRP_SEAM_MASK ((1u << 1) | (1u << 3) | (1u << 4) | (1u << 6) | (1u << 7) | (1u << 8) | (1u << 9) | (1u << 13) | (1u << 14) | (1u << 15))
#endif

struct Args { const void* in[22]; float* out; unsigned char* ws; int ph_lo, ph_hi, coop, pad; };
constexpr int NPHASES = 17;

__global__ void __launch_bounds__(NTHR, 2) mk_fwd(Args a) {
    extern __shared__ __attribute__((aligned(16))) unsigned char lds_raw[];
    LAS unsigned char* lds = (LAS unsigned char*)lds_raw;
    cg::grid_group grid = cg::this_grid();
    const int G = gridDim.x;
#define NGW (G * NWAVES)
    const int ph_lo = KARG_INT(0), ph_hi = KARG_INT(1), coop = KARG_INT(2);
    int ph = 0;
#ifndef STRESS_DELAY
#define STRESS_DELAY 0
#endif
#ifndef DUP_MASK
#define DUP_MASK 0u
#endif
    volatile LAS unsigned* bar_st = (volatile LAS unsigned*)(lds + 147456 - 64);
    if (threadIdx.x < 2) bar_st[threadIdx.x] = 0u;
    __syncthreads();
    XcdBarrier xbar; xbar.bar = (unsigned*)WS_P; xbar.x = 0; xbar.st = bar_st;
    bool bar_ready = false;
#define BEGIN_PHASE if (ph_lo <= ph && ph < ph_hi) { if (STRESS_DELAY && (int)(blockIdx.x & 7) == ((ph * 3) & 7)) { const unsigned long long t0_ = __builtin_amdgcn_s_memrealtime(); while (__builtin_amdgcn_s_memrealtime() - t0_ < 15000ull) __builtin_amdgcn_s_sleep(8); } for (int rep_ = 0; rep_ < ((((unsigned)DUP_MASK >> ph) & 1u) ? 2 : 1); ++rep_) { unsigned char* ws = WS_P; float* out = OUT_P; bf16* XN = (bf16*)(ws + WS_XN); bf16* BIG = (bf16*)(ws + WS_BIG); f32x2v* TAB = (f32x2v*)(ws + WS_ROPE); int tid_ = threadIdx.x, bx_ = blockIdx.x; asm volatile("" : "+v"(tid_), "+s"(bx_)); const int tid = tid_, bx = bx_, lane = tid & 63, wave = __builtin_amdgcn_readfirstlane(tid >> 6), gw = bx * NWAVES + wave; (void)bx; (void)out; (void)XN; (void)BIG; (void)TAB; (void)lane; (void)tid; (void)wave; (void)gw;
#define END_PHASE } if (coop && ph + 1 < ph_hi) { if (!bar_ready) { grid.sync(); xbar = xcd_barrier_post((unsigned*)WS_P, bar_st); bar_ready = true; } else if (((unsigned)GRP_SEAM_MASK >> ph) & 1u & (unsigned)((G & 7) == 0)) { grp_barrier((unsigned*)WS_P, (int)(blockIdx.x & 7), (unsigned)G >> 3); } else { xbar.bar = (unsigned*)WS_P; xcd_barrier(xbar); } } } ++ph;

    BEGIN_PHASE
        if (bx == 0) for (int i = tid; i < 4096; i += NTHR) ((unsigned*)ws)[i] = 0u;
        { v4u* z = (v4u*)(ws + WS_RSS + RSS_SZ); const int nz = (int)((WS_STAT_END - WS_RSS - RSS_SZ) / 16);
          for (int i = bx * NTHR + tid; i < nz; i += G * NTHR) z[i] = (v4u){0u, 0u, 0u, 0u}; }
        { const float* x_in = IN_F(0); u64_t* rss0 = (u64_t*)(ws + WS_RSS);
          for (int m = gw; m < M; m += NGW) row_bf16_ss(x_in + (size_t)m * DM, XN + (size_t)m * DM, rss0 + m, lane); }
        LAS float* scr = (LAS float*)(lds + wave * 16640);
        for (int i = 0; i < 2; ++i) for (int w = 0; w < 2; ++w) {
            transpose_matrix((w ? IN_F(7) : IN_F(3)) + (size_t)i * DM * 2 * FF, DM, 2 * FF, (bf16*)(ws + WS_WFI + (size_t)(2 * i + w) * WFI_SZ), 1, 1.f, (w ? IN_F(6) : IN_F(2)) + i * DM, scr, gw, NGW, lane);
            transpose_matrix((w ? IN_F(8) : IN_F(4)) + (size_t)i * FF * DM, FF, DM, (bf16*)(ws + WS_WFO + (size_t)(2 * i + w) * WFO_SZ), 0, 1.f, nullptr, scr, gw, NGW, lane);
        }
        transpose_matrix(IN_F(9), DM, 2 * SW, (bf16*)(ws + WS_WSI), 0, 1.f, IN_F(5), scr, gw, NGW, lane);
        transpose_matrix(IN_F(14), SW, DM, (bf16*)(ws + WS_WSO), 0, 1.f, nullptr, scr, gw, NGW, lane);
        transpose_matrix(IN_F(15), DM, MLA_IN, (bf16*)(ws + WS_WMI), 0, 1.f, IN_F(5) + DM, scr, gw, NGW, lane);
        transpose_matrix(IN_F(17), 512, QUP_N, (bf16*)(ws + WS_WQU), 0, C2, IN_F(16), scr, gw, NGW, lane);
        transpose_matrix(IN_F(19), 512, KVUP_N, (bf16*)(ws + WS_WKV), 0, 1.f, IN_F(18), scr, gw, NGW, lane);
        transpose_matrix(IN_F(20), DM, DM, (bf16*)(ws + WS_WMO), 0, 1.f, nullptr, scr, gw, NGW, lane);
        { v4u* padp = (v4u*)(ws + WS_WMI + (size_t)MLA_IN * DM * 2); const int npad = (MLA_INP - MLA_IN) * DM * 2 / 16;
          for (int i = bx * NTHR + tid; i < npad; i += G * NTHR) padp[i] = (v4u){0u, 0u, 0u, 0u}; }
        for (int idx = bx * NTHR + tid; idx < M * 32; idx += G * NTHR) { const int m = idx >> 5, f = idx & 31;
            const float inv = __builtin_amdgcn_exp2f(-(float)f * (13.287712379549449f / 32.f)); const float ang = (float)((const int*)KARG_PTR(1))[m] * inv;
            double rev = (double)ang * 0.15915494309189535; rev -= __builtin_rint(rev); const float fr = (float)rev;
            TAB[idx] = (f32x2v){__builtin_amdgcn_cosf(fr), __builtin_amdgcn_sinf(fr)}; }
    END_PHASE

#pragma nounroll
    for (int f = 0; f < 4; ++f) {
        const int layer = f >> 1;
        const int ni = f + (f > 0 ? 1 : 0) + (f > 2 ? 1 : 0);
        BEGIN_PHASE
            pg8::Gemm gm{XN, (const bf16*)(ws + WS_WFI + (size_t)f * WFI_SZ), M, 2 * FF, DM, DM}; pg8::StaticOrder S; S.init(M, 2 * FF, G, bx);
            pg8::EpiSwiglu E{(unsigned)WS_BIG, FF, (unsigned)(WS_RSS + (size_t)ni * RSS_SZ), 1.f / DM};
#ifndef DIS_G0
            pg8::gemm_phase<pg8::EpiSwiglu, pg8::StaticOrder, true, true>(lds, gm, S, E);
#endif
        END_PHASE
        BEGIN_PHASE
            pg8::Gemm gm{BIG, (const bf16*)(ws + WS_WFO + (size_t)f * WFO_SZ), M, DM, FF, FF}; pg8::StaticOrder S; S.init(M, DM, G, bx);
            pg8::EpiResid E{f == 0 ? 1 : 0, 0.5f, (unsigned)(WS_RSS + (size_t)(ni + 1) * RSS_SZ)};
#ifndef DIS_G1
            pg8::gemm_phase<pg8::EpiResid, pg8::StaticOrder, true, true>(lds, gm, S, E);
#endif
        END_PHASE
        if ((f & 1) == 0) {
            const int mi = 1 + 3 * layer;
            if (layer == 0) {
                BEGIN_PHASE
                    pg8::Gemm gm{XN, (const bf16*)(ws + WS_WSI), M, 2 * SW, DM, DM}; pg8::StaticOrder S; S.init(M, 2 * SW, G, bx);
                    pg8::EpiBf16<1, 1> E{(unsigned)WS_BIG, SW, SW, (unsigned)((size_t)M * SW), (unsigned)(WS_RSS + (size_t)mi * RSS_SZ), 1.f / DM, (unsigned)WS_VSUM, (unsigned)WS_VSQ};
#ifndef DIS_G2
                    pg8::gemm_phase<pg8::EpiBf16<1, 1>, pg8::StaticOrder, true, true>(lds, gm, S, E);
#endif
                END_PHASE
                BEGIN_PHASE
#ifndef DIS_SGU
                    sgu_spatial_phase(lds, BIG, BIG + (size_t)M * SW, BIG + (size_t)M * SW, (const u64_t*)(ws + WS_VSUM), (const u64_t*)(ws + WS_VSQ), IN_F(10), IN_F(11), IN_F(12), IN_F(13), G, bx);
#endif
                END_PHASE
            } else {
#define PROJ ((bf16*)(ws + WS_PROJ))
#define KR ((bf16*)(ws + WS_KR))
#define Qb BIG
#define KVb (BIG + (size_t)M * QUP_N)
#define Ob ((bf16*)(ws + WS_O))
                BEGIN_PHASE
                    pg8::Gemm gm{XN, (const bf16*)(ws + WS_WMI), M, 1024, DM, DM}; pg8::StaticOrder S; S.init(M, 1024, G, bx);
                    pg8::EpiBf16<0, 2> E{(unsigned)WS_PROJ, MLA_INP, 0, 0u, (unsigned)(WS_RSS + (size_t)mi * RSS_SZ), 1.f / DM, (unsigned)WS_QSS, (unsigned)WS_KVSS};
#ifndef DIS_G3
                    pg8::gemm_phase<pg8::EpiBf16<0, 2>, pg8::StaticOrder, true, true>(lds, gm, S, E);
#endif
                    { pg8::Gemm gs{XN, (const bf16*)(ws + WS_WMI) + (size_t)1024 * DM, M, 1024, 512, DM, DM, 1024u, 1024u}; pg8::StaticOrder S2; S2.init(M, 1024, G, bx);
                      pg8::EpiPartial E2{(unsigned)WS_O};
                      pg8::gemm_phase<pg8::EpiPartial, pg8::StaticOrder, true, true>(lds, gs, S2, E2); }
                END_PHASE
                BEGIN_PHASE
                    for (int m = gw; m < M; m += NGW) if (lane < 32) { const float* part = (const float*)(ws + WS_O) + (size_t)m * 64;
                        const float rs = __builtin_amdgcn_rsqf(stat_get(((const u64_t*)(ws + WS_RSS + (size_t)mi * RSS_SZ))[m]) * (1.f / DM) + EPS);
                        const float x1 = ((part[lane] + part[(size_t)M * 64 + lane]) + (part[(size_t)2 * M * 64 + lane] + part[(size_t)3 * M * 64 + lane])) * rs;
                        const float x2 = ((part[32 + lane] + part[(size_t)M * 64 + 32 + lane]) + (part[(size_t)2 * M * 64 + 32 + lane] + part[(size_t)3 * M * 64 + 32 + lane])) * rs;
                        const f32x2v cs = TAB[(size_t)m * 32 + lane]; const unsigned w = pk2(x1 * cs.x - x2 * cs.y, x1 * cs.y + x2 * cs.x);
                        KR[(size_t)m * 64 + lane] = (bf16)(w & 0xffffu); KR[(size_t)m * 64 + 32 + lane] = (bf16)(w >> 16); }
                    { pg8::Gemm gm{PROJ, (const bf16*)(ws + WS_WQU), M, QUP_N, 512, MLA_INP}; pg8::StaticOrder S; S.init(M, QUP_N, G, bx);
                      pg8::EpiBf16<0, 0> E{(unsigned)WS_BIG, QUP_N, 0, 0u, (unsigned)WS_QSS, 1.f / 512, 0u, 0u};
#ifndef DIS_G4
                      pg8::gemm_phase<pg8::EpiBf16<0, 0>, pg8::StaticOrder, true, true>(lds, gm, S, E);
#endif
                    }
                    { pg8::Gemm gm{PROJ + 512, (const bf16*)(ws + WS_WKV), M, KVUP_N, 512, MLA_INP}; pg8::StaticOrder S; S.init(M, KVUP_N, G, bx);
                      pg8::EpiBf16<0, 0> E{(unsigned)(WS_BIG + (size_t)M * QUP_N * 2), KVUP_N, 0, 0u, (unsigned)WS_KVSS, 1.f / 512, 0u, 0u};
#ifndef DIS_G5
                      pg8::gemm_phase<pg8::EpiBf16<0, 0>, pg8::StaticOrder, true, true>(lds, gm, S, E);
#endif
                    }
                END_PHASE
                BEGIN_PHASE
#ifndef DIS_ATTN
                    attn_phase(lds, Qb, KVb, KR, TAB, Ob, G, bx);
#endif
                END_PHASE
            }
            BEGIN_PHASE
                pg8::Gemm gm{layer ? Ob : BIG + (size_t)M * SW, (const bf16*)(ws + (layer ? WS_WMO : WS_WSO)), M, DM, layer ? DM : SW, layer ? DM : SW}; pg8::StaticOrder S; S.init(M, DM, G, bx);
                pg8::EpiResid E{0, 1.0f, (unsigned)(WS_RSS + (size_t)(mi + 1) * RSS_SZ)};
#ifndef DIS_G6
                pg8::gemm_phase<pg8::EpiResid, pg8::StaticOrder, true, true>(lds, gm, S, E);
#endif
            END_PHASE
        }
    }
    BEGIN_PHASE
        const float* g = IN_F(21); const u64_t* rss = (const u64_t*)(ws + WS_RSS + 6 * RSS_SZ);
        if ((G & 7) == 0) { const int gx = bx & 7, widx = (bx >> 3) * NWAVES + wave, wstr = (G >> 3) * NWAVES;
            for (int r = widx; r < M / 8; r += wstr) { const int m = gx * (M / 8) + r; rms_row_out(XN + (size_t)m * DM, g, stat_get(rss[m]), out + (size_t)m * DM, lane); } }
        else for (int m = gw; m < M; m += NGW) rms_row_out(XN + (size_t)m * DM, g, stat_get(rss[m]), out + (size_t)m * DM, lane);
    END_PHASE
#undef BEGIN_PHASE
#undef END_PHASE
}

extern "C" void kernel_launch(void* const* d_in, const int* in_sizes, int n_in, void* d_out, int out_size, void* d_ws, size_t ws_size, hipStream_t stream) {
    static int grid = 0;
    if (grid == 0) {
        if (n_in != 22 || in_sizes[0] != M * DM || out_size != M * DM || ws_size < WS_END) { fprintf(stderr, "kernel_launch: unexpected shapes (n_in %d, in0 %d, out %d, ws %zu)\n", n_in, n_in > 0 ? in_sizes[0] : -1, out_size, ws_size); grid = -1; return; }
        int dev = 0, cus = 0, per_cu = 0;
        if (hipGetDevice(&dev) != hipSuccess || hipDeviceGetAttribute(&cus, hipDeviceAttributeMultiprocessorCount, dev) != hipSuccess) { grid = -1; return; }
        if (hipFuncSetAttribute((const void*)mk_fwd, hipFuncAttributeMaxDynamicSharedMemorySize, LDS_BYTES) != hipSuccess) { fprintf(stderr, "kernel_launch: hipFuncSetAttribute failed\n"); grid = -1; return; }
        if (hipOccupancyMaxActiveBlocksPerMultiprocessor(&per_cu, (const void*)mk_fwd, NTHR, LDS_BYTES) != hipSuccess || per_cu < 1) { fprintf(stderr, "kernel_launch: occupancy query says %d blocks per CU\n", per_cu); per_cu = 1; }
        (void)hipGetLastError();
        grid = cus;
    }
    if (grid < 0) return;
    Args a{};
    for (int i = 0; i < 22; ++i) a.in[i] = d_in[i];
    a.out = (float*)d_out; a.ws = (unsigned char*)d_ws;
#if MK_PER_PHASE
    for (int ph = 0; ph < NPHASES; ++ph) { a.ph_lo = ph; a.ph_hi = ph + 1; a.coop = 0;
        hipLaunchKernelGGL(mk_fwd, dim3(grid), dim3(NTHR), LDS_BYTES, stream, a); }
#else
    a.ph_lo = 0; a.ph_hi = NPHASES; a.coop = 1;
    void* args[] = {&a};
    hipError_t e = hipLaunchCooperativeKernel((const void*)mk_fwd, dim3(grid), dim3(NTHR), args, LDS_BYTES, stream);
    if (e != hipSuccess) fprintf(stderr, "kernel_launch: cooperative launch failed: %s (grid %d)\n", hipGetErrorString(e), grid);
#endif
}
```

```cpp
#include <hip/hip_runtime.h>
#include <hip/hip_cooperative_groups.h>
#include <cstdio>
#include <cstdint>
namespace cg = cooperative_groups;
constexpr int NWAVES = 8, NTHR = 512;
constexpr int M = 16384, SEQ = 8192, DM = 2048, FF = 5632, SW = 4096;
constexpr int NH = 16, QKD = 192, MLA_IN = 1088, MLA_INP = 1280, QUP_N = 3072, KVUP_N = 4096;
constexpr float EPS = 1e-6f;
constexpr float C2 = 0.07216878364870322f * 1.4426950408889634f;

constexpr size_t MiB = 1u << 20;
constexpr size_t WS_ROPE = 1 * MiB;
constexpr size_t WS_RSS = 5 * MiB, RSS_SZ = 131072, WS_QSS = WS_RSS + 7 * RSS_SZ, WS_KVSS = WS_QSS + RSS_SZ, WS_VSUM = WS_KVSS + RSS_SZ, WS_VSQ = WS_VSUM + RSS_SZ, WS_STAT_END = WS_VSQ + RSS_SZ;
constexpr size_t WS_WFI = 8 * MiB, WFI_SZ = 44 * MiB, WS_WFO = 184 * MiB, WFO_SZ = 22 * MiB;
constexpr size_t WS_WSI = 272 * MiB, WS_WSO = 304 * MiB, WS_WMI = 320 * MiB, WS_WQU = 325 * MiB, WS_WKV = 328 * MiB, WS_WMO = 332 * MiB;
constexpr size_t WS_XN = 340 * MiB, WS_BIG = 404 * MiB, WS_PROJ = 660 * MiB, WS_O = 700 * MiB, WS_KR = 764 * MiB, WS_END = 766 * MiB;
constexpr int LDS_BYTES = 147456;

#define GAS __attribute__((address_space(1)))
#define KARG_U64(i) (((const volatile unsigned long long __attribute__((address_space(4)))*)__builtin_amdgcn_kernarg_segment_ptr())[(i)])
#define KARG_PTR(i) ((const void*)(const GAS void*)KARG_U64(i))
#define KARG_INT(i) (((const volatile int __attribute__((address_space(4)))*)__builtin_amdgcn_kernarg_segment_ptr())[48 + (i)])
#define IN_F(i) ((const float*)KARG_PTR(i))
#define OUT_P ((float*)KARG_PTR(22))
#define WS_P ((unsigned char*)KARG_PTR(23))
typedef unsigned long long u64_t;
__device__ __forceinline__ void stat_add(u64_t* p, float v) { atomicAdd(p, (u64_t)__float2ll_rn(v * 16777216.0f)); }
__device__ __forceinline__ float stat_get(u64_t v) { return (float)(long long)v * (1.0f / 16777216.0f); }
__device__ __forceinline__ float xrow_sum(float v) {
    { auto r = __builtin_amdgcn_permlane16_swap(__float_as_uint(v), __float_as_uint(v), false, false); v = __uint_as_float(r[0]) + __uint_as_float(r[1]); }
    { auto r = __builtin_amdgcn_permlane32_swap(__float_as_uint(v), __float_as_uint(v), false, false); v = __uint_as_float(r[0]) + __uint_as_float(r[1]); }
    return v;
}
namespace pg8 {
#define PG8_LAS __attribute__((address_space(3)))
typedef unsigned short bf16_t;
typedef short bf16x8 __attribute__((ext_vector_type(8)));
typedef float f32x4 __attribute__((ext_vector_type(4)));
typedef unsigned u32x4 __attribute__((ext_vector_type(4)));
typedef unsigned u32x2 __attribute__((ext_vector_type(2)));
constexpr int BM = 256, BK = 64, HALF = 128, HTB = HALF * BK * 2  , STAGE_BYTES = 8 * HTB, NXCD = 8, WGM = 8;

__host__ __device__ __forceinline__ int lds_byte(int r, int c) { const int st = (r >> 4) * 2 + (c >> 5), rr = r & 15, cc = c & 31, ob = rr * 64 + cc * 2; return st * 1024 + (ob ^ (((ob >> 9) & 1) << 5)); }
__host__ __device__ __forceinline__ void stage_rc(int b, int& R, int& C) { const int st = b / 1024, sb = b % 1024, swz = sb ^ (((sb >> 9) & 1) << 5); R = (st >> 1) * 16 + swz / 64; C = (st & 1) * 32 + (swz % 64) / 2; }
__host__ __device__ __forceinline__ int perm32(int rho) { const int n = rho >> 4, i = rho & 15; return 8 * (i >> 2) + 4 * n + (i & 3); }

struct Unit { int pm, pn; };
struct Gemm { const bf16_t* A; const bf16_t* Bt; int M, N, K, lda; int ldb; unsigned a_pn_step, b_pn_step; };

struct StaticOrder {
    int nM, nN, nwg, G, c;
    __host__ __device__ void init(int M, int N, int G_, int c_) { nM = M / BM; nN = N / BM; nwg = nM * nN; G = G_; c = c_; }
    __host__ __device__ bool next(int i, Unit& u) const {
        const long L = (long)i * G + c; if (L >= nwg) return false;
        int wgid = (int)L; { const int q = nwg / NXCD, r = nwg % NXCD, xcd = wgid % NXCD, off = wgid / NXCD; wgid = (xcd < r ? xcd * (q + 1) : r * (q + 1) + (xcd - r) * q) + off; }
        const int nig = WGM * nN, gid = wgid / nig, fm = gid * WGM, gsz = (nM - fm) < WGM ? (nM - fm) : WGM;
        u.pm = fm + ((wgid % nig) % gsz); u.pn = (wgid % nig) / gsz; return true;
    }
    __device__ __forceinline__ void a_ready(const Unit&) const {}
    __device__ __forceinline__ void done(const Unit&) const {}
};

__device__ __forceinline__ unsigned cvt_pk_bf16(float lo, float hi) { unsigned r; asm volatile("v_cvt_pk_bf16_f32 %0, %1, %2" : "=v"(r) : "v"(lo), "v"(hi)); return r; }
typedef float f32x2 __attribute__((ext_vector_type(2)));
__device__ __forceinline__ float fast_sigmoid(float x) { return __builtin_amdgcn_rcpf(1.0f + __builtin_amdgcn_exp2f(-1.4426950408889634f * x)); }
__device__ __forceinline__ float gelu_tanh(float x) { const float k1 = -2.0f * 0.7978845608028654f * 1.4426950408889634f, k2 = k1 * 0.044715f;
    const float p = __builtin_fmaf(k2, x * x, k1); return x * __builtin_amdgcn_rcpf(1.0f + __builtin_amdgcn_exp2f(p * x)); }
__device__ __forceinline__ float silu_f(float x) { return x * fast_sigmoid(x); }

constexpr float RS_EPS = 1e-6f;
__device__ __forceinline__ float row_rstd(float ss, float inv_n) { return __builtin_amdgcn_rsqf(ss * inv_n + RS_EPS); }
__device__ __forceinline__ void rss_prefetch(PG8_LAS unsigned char* xl, const u64_t* rss, const Unit& u, int wr, int wid, int lane) {
#pragma unroll
    for (int j = 0; j < 4; ++j) __builtin_amdgcn_global_load_lds((const unsigned*)(rss + u.pm * BM + (j >> 1) * HALF + wr * 64) + (j & 1) * 64 + lane, (PG8_LAS unsigned*)(xl + wid * 1024 + j * 256), 4, 0, 0);
}
__device__ __forceinline__ void rss_wait() { asm volatile("s_waitcnt vmcnt(16)" ::: "memory"); }
__device__ __forceinline__ float rss_read(const PG8_LAS unsigned char* xl, int wid, int ai, int m, int fr) {
    const u32x2 w = *(const PG8_LAS u32x2*)(xl + wid * 1024 + ai * 512 + (m * 16 + fr) * 8); return __builtin_fmaf((float)w.y, 256.0f, (float)w.x * (1.0f / 16777216.0f)); }
template <int ACT  , int STAT> struct EpiBf16 {
    static constexpr bool PERM = true, AFTER_DRAIN = false;
    unsigned o_off; int ldc; int split_cols; unsigned split_stride;
    unsigned rss_off; float inv_n; unsigned st0_off, st1_off;
    __device__ __forceinline__ void prefetch(PG8_LAS unsigned char* xl, const Unit& u, int wr, int wid, int lane) const { rss_prefetch(xl, (const u64_t*)(WS_P + rss_off), u, wr, wid, lane); }
    __device__ __forceinline__ void operator()(const f32x4 (&acc)[2][2][4][2], const Unit& u, int wr, int wc, int fr, int fq, const PG8_LAS unsigned char* xl, int wid) const {
        rss_wait();
        unsigned char* ws_ = WS_P; u64_t* st0 = (u64_t*)(ws_ + st0_off); u64_t* st1 = (u64_t*)(ws_ + st1_off);
        const int row0 = u.pm * BM + wr * 64 + fr; int colt = u.pn * BM; bf16_t* base = (bf16_t*)(ws_ + o_off); int t = 0;
        if (split_cols) { t = colt / split_cols; base += (size_t)t * split_stride; colt -= t * split_cols; }
        const int col0 = colt + wc * 32 + 8 * fq;
        const bool do_stat = (STAT == 1) ? (t == 1) : (STAT == 2) ? (u.pn < 4) : false;
#pragma unroll
        for (int ai = 0; ai < 2; ++ai)
#pragma unroll
            for (int m = 0; m < 4; ++m) { const int row = row0 + ai * HALF + m * 16; bf16_t* rowp = base + (size_t)row * ldc + col0;
                const float rs = row_rstd(rss_read(xl, wid, ai, m, fr), inv_n); float s1 = 0.f, s2 = 0.f;
#pragma unroll
                for (int bj = 0; bj < 2; ++bj) { f32x4 v0 = acc[ai][bj][m][0] * rs, v1 = acc[ai][bj][m][1] * rs;
                    if (ACT == 1) {
                        const float k1 = -2.0f * 0.7978845608028654f * 1.4426950408889634f, k2 = k1 * 0.044715f;
                        f32x4 z0 = (v0 * v0 * k2 + k1) * v0, z1 = (v1 * v1 * k2 + k1) * v1;
#pragma unroll
                        for (int e = 0; e < 4; ++e) { z0[e] = __builtin_amdgcn_exp2f(z0[e]); z1[e] = __builtin_amdgcn_exp2f(z1[e]); }
                        z0 = z0 + 1.0f; z1 = z1 + 1.0f;
#pragma unroll
                        for (int e = 0; e < 4; ++e) { z0[e] = __builtin_amdgcn_rcpf(z0[e]); z1[e] = __builtin_amdgcn_rcpf(z1[e]); }
                        v0 = v0 * z0; v1 = v1 * z1; }
                    if (STAT != 0) { const f32x4 t1 = v0 + v1, t2 = v0 * v0 + v1 * v1; s1 += (t1[0] + t1[1]) + (t1[2] + t1[3]); s2 += (t2[0] + t2[1]) + (t2[2] + t2[3]); }
                    u32x4 w; w.x = cvt_pk_bf16(v0[0], v0[1]); w.y = cvt_pk_bf16(v0[2], v0[3]); w.z = cvt_pk_bf16(v1[0], v1[1]); w.w = cvt_pk_bf16(v1[2], v1[3]);
                    *(u32x4*)(rowp + bj * HALF) = w; }
                if (STAT != 0) { if (do_stat) {
                    s1 = xrow_sum(s1); s2 = xrow_sum(s2);
                    if (fq == 0) { if (STAT == 1) { stat_add(st0 + row, s1); stat_add(st1 + row, s2); } else stat_add((u.pn < 2 ? st0 : st1) + row, s2); } } } }
    }
};
struct EpiPartial {
    static constexpr bool PERM = true, AFTER_DRAIN = false;
    unsigned o_off;
    __device__ __forceinline__ void prefetch(PG8_LAS unsigned char*, const Unit&, int, int, int) const {}
    __device__ __forceinline__ void operator()(const f32x4 (&acc)[2][2][4][2], const Unit& u, int wr, int wc, int fr, int fq, const PG8_LAS unsigned char*, int) const {
        if (wc < 2) { float* P = (float*)(WS_P + o_off) + (size_t)u.pn * M * 64 + wc * 32 + 8 * fq;
#pragma unroll
            for (int ai = 0; ai < 2; ++ai)
#pragma unroll
                for (int m = 0; m < 4; ++m) { float* p = P + (size_t)(u.pm * BM + ai * HALF + wr * 64 + m * 16 + fr) * 64; *(f32x4*)p = acc[ai][0][m][0]; *(f32x4*)(p + 4) = acc[ai][0][m][1]; } }
    }
};
struct EpiSwiglu {
    static constexpr bool PERM = true, AFTER_DRAIN = false;
    unsigned o_off; int ldc; unsigned rss_off; float inv_n;
    __device__ __forceinline__ void prefetch(PG8_LAS unsigned char* xl, const Unit& u, int wr, int wid, int lane) const { rss_prefetch(xl, (const u64_t*)(WS_P + rss_off), u, wr, wid, lane); }
    __device__ __forceinline__ void operator()(const f32x4 (&acc)[2][2][4][2], const Unit& u, int wr, int wc, int fr, int fq, const PG8_LAS unsigned char* xl, int wid) const {
        rss_wait();
        unsigned char* ws_ = WS_P; bf16_t* O = (bf16_t*)(ws_ + o_off);
        const int row0 = u.pm * BM + wr * 64 + fr; const int col0 = u.pn * HALF + wc * 32 + 8 * fq;
#pragma unroll
        for (int ai = 0; ai < 2; ++ai)
#pragma unroll
            for (int m = 0; m < 4; ++m) { const int row = row0 + ai * HALF + m * 16; bf16_t* rowp = O + (size_t)row * ldc + col0;
                const float rs = row_rstd(rss_read(xl, wid, ai, m, fr), inv_n);
                const float ce = -1.4426950408889634f * rs, rs2 = rs * rs;
                f32x4 g0 = acc[ai][0][m][0], g1 = acc[ai][0][m][1]; const f32x4 u0 = acc[ai][1][m][0], u1 = acc[ai][1][m][1];
                const f32x4 z0 = g0 * ce, z1 = g1 * ce; f32x4 d0, d1;
#pragma unroll
                for (int e = 0; e < 4; ++e) { d0[e] = __builtin_amdgcn_exp2f(z0[e]); d1[e] = __builtin_amdgcn_exp2f(z1[e]); }
                d0 = d0 + 1.0f; d1 = d1 + 1.0f;
#pragma unroll
                for (int e = 0; e < 4; ++e) { d0[e] = __builtin_amdgcn_rcpf(d0[e]); d1[e] = __builtin_amdgcn_rcpf(d1[e]); }
                g0 = (g0 * u0) * (d0 * rs2); g1 = (g1 * u1) * (d1 * rs2);
                u32x4 w; w.x = cvt_pk_bf16(g0[0], g0[1]); w.y = cvt_pk_bf16(g0[2], g0[3]); w.z = cvt_pk_bf16(g1[0], g1[1]); w.w = cvt_pk_bf16(g1[2], g1[3]);
                *(u32x4*)rowp = w; }
    }
};
struct EpiResid {
    static constexpr bool PERM = true, AFTER_DRAIN = false;
    int use_in; float scale; unsigned rss_off;
    __device__ __forceinline__ void prefetch(PG8_LAS unsigned char*, const Unit&, int, int, int) const {}
    __device__ __forceinline__ void operator()(const f32x4 (&acc)[2][2][4][2], const Unit& u, int wr, int wc, int fr, int fq, const PG8_LAS unsigned char*, int) const {
        unsigned char* ws_ = WS_P; const float* xin = IN_F(0); bf16_t* xn = (bf16_t*)(ws_ + WS_XN); u64_t* rss_out = (u64_t*)(ws_ + rss_off); constexpr int ldc = DM;
        const int col0 = u.pn * BM + wc * 32 + 8 * fq;
#pragma unroll
        for (int ai = 0; ai < 2; ++ai)
#pragma unroll
            for (int m = 0; m < 4; ++m) { const int row = u.pm * BM + ai * HALF + wr * 64 + m * 16 + fr; const size_t off = (size_t)row * ldc + col0;
                f32x4 bs[2][2];
                if (use_in) {
#pragma unroll
                    for (int bj = 0; bj < 2; ++bj)
#pragma unroll
                        for (int n = 0; n < 2; ++n) bs[bj][n] = *(const f32x4*)(xin + off + bj * HALF + n * 4);
                } else {
#pragma unroll
                    for (int bj = 0; bj < 2; ++bj) { const u32x4 w = *(const u32x4*)(xn + off + bj * HALF);
                        bs[bj][0] = (f32x4){__uint_as_float(w.x << 16), __uint_as_float(w.x & 0xffff0000u), __uint_as_float(w.y << 16), __uint_as_float(w.y & 0xffff0000u)};
                        bs[bj][1] = (f32x4){__uint_as_float(w.z << 16), __uint_as_float(w.z & 0xffff0000u), __uint_as_float(w.w << 16), __uint_as_float(w.w & 0xffff0000u)}; }
                }
                float s2 = 0.f;
#pragma unroll
                for (int bj = 0; bj < 2; ++bj) { const f32x4 v0 = bs[bj][0] + acc[ai][bj][m][0] * scale, v1 = bs[bj][1] + acc[ai][bj][m][1] * scale;
                    u32x4 w; w.x = cvt_pk_bf16(v0[0], v0[1]); w.y = cvt_pk_bf16(v0[2], v0[3]); w.z = cvt_pk_bf16(v1[0], v1[1]); w.w = cvt_pk_bf16(v1[2], v1[3]);
                    *(u32x4*)(xn + off + bj * HALF) = w;
                    { const f32x4 t2 = v0 * v0 + v1 * v1; s2 += (t2[0] + t2[1]) + (t2[2] + t2[3]); } }
                s2 = xrow_sum(s2);
                if (fq == 0) stat_add(rss_out + row, s2);
                if (m == 3) asm volatile("" ::: "memory"); }
    }
};
template <class Epi, class Sched, bool ALIGN_EPI = false, bool SP2 = false>
__device__ __forceinline__ void gemm_phase(PG8_LAS unsigned char* lds, const Gemm g, const Sched& S, const Epi& E) {
    int tid_ = threadIdx.x; asm volatile("" : "+v"(tid_));
    const int tid = tid_, wid = __builtin_amdgcn_readfirstlane(tid >> 6), lane = tid & 63, wr = wid >> 2, wc = wid & 3, fr = lane & 15, fq = lane >> 4;
    const int K = g.K, nt = K / BK;
    unsigned voffA[2], voffB[2];
#pragma unroll
    for (int i = 0; i < 2; ++i) { int R, C; stage_rc(tid * 16 + i * 8192, R, C); const int Rb = Epi::PERM ? ((R & ~31) + perm32(R & 31)) : R;
        voffA[i] = (unsigned)(R * g.lda + C) * 2u; voffB[i] = (unsigned)(Rb * (g.ldb ? g.ldb : K) + C) * 2u; }
    const size_t kstep = (size_t)(BK * 2);
    const size_t hstep = (size_t)HALF * (g.ldb ? g.ldb : K) * 2;
    const size_t tstep = 2 * hstep;
    const size_t hstepA = (size_t)HALF * g.lda * 2, tstepA = 2 * hstepA; const size_t bstep = g.b_pn_step ? (size_t)g.b_pn_step : tstep, astep = (size_t)g.a_pn_step;
    const unsigned ldsw = (unsigned)wid * 1024u;
    const int aoff = lds_byte(wr * 64 + fr, fq * 8), boff = lds_byte(wc * 32 + fr, fq * 8);
#define PG8_SA(b, h) (((b) * 2 + (h)) * HTB)
#define PG8_SB(b, h) ((4 + (b) * 2 + (h)) * HTB)
#define PG8_STAGE(bufoff, gbase, voff) do { _Pragma("unroll") for (int _i = 0; _i < 2; ++_i) \
        __builtin_amdgcn_global_load_lds((const unsigned*)((const char*)(gbase) + (voff)[_i]), (PG8_LAS unsigned*)(lds + (bufoff) + ldsw + _i * 8192), 16, 0, 0); } while (0)
#define PG8_LDA(dst, b, h) do { _Pragma("unroll") for (int m = 0; m < 4; ++m) _Pragma("unroll") for (int k = 0; k < 2; ++k) dst[m][k] = *(const PG8_LAS bf16x8*)(lds + PG8_SA(b, h) + aoff + m * 2048 + k * 1024); } while (0)
#define PG8_LDB(dst, b, h) do { _Pragma("unroll") for (int n = 0; n < 2; ++n) _Pragma("unroll") for (int k = 0; k < 2; ++k) dst[n][k] = *(const PG8_LAS bf16x8*)(lds + PG8_SB(b, h) + boff + n * 2048 + k * 1024); } while (0)
#define PG8_MMA(ai, bj, At, Bt) do { __builtin_amdgcn_s_setprio(1); _Pragma("unroll") for (int m = 0; m < 4; ++m) _Pragma("unroll") for (int n = 0; n < 2; ++n) _Pragma("unroll") for (int k = 0; k < 2; ++k) \
        acc[ai][bj][m][n] = __builtin_amdgcn_mfma_f32_16x16x32_bf16(Bt[n][k], At[m][k], acc[ai][bj][m][n], 0, 0, 0); __builtin_amdgcn_s_setprio(0); } while (0)
#define PG8_WAIT_V(n) asm volatile("s_waitcnt vmcnt(" #n ")" ::: "memory")
#define PG8_WAIT_L(n) asm volatile("s_waitcnt lgkmcnt(" #n ")" ::: "memory")
#define PG8_BAR __builtin_amdgcn_s_barrier()
#define PG8_SCHED __builtin_amdgcn_sched_barrier(0)
    Unit cur, nxt; int ui = 0;
    if (!S.next(0, cur)) return;
    f32x4 acc[2][2][4][2];
#pragma unroll
    for (int a = 0; a < 2; ++a)
#pragma unroll
        for (int b = 0; b < 2; ++b)
#pragma unroll
            for (int m = 0; m < 4; ++m)
#pragma unroll
                for (int n = 0; n < 2; ++n) acc[a][b][m][n] = (f32x4){0.f, 0.f, 0.f, 0.f};
    bf16x8 At[4][2], B0[2][2], B1[2][2];
    const char* cA = (const char*)g.A + (size_t)cur.pm * tstepA + (size_t)cur.pn * astep; const char* cB = (const char*)g.Bt + (size_t)cur.pn * bstep;
    S.a_ready(cur);
    if constexpr (SP2) {
        PG8_STAGE(PG8_SB(0, 0), cB, voffB); PG8_STAGE(PG8_SB(0, 1), cB + hstep, voffB); PG8_STAGE(PG8_SA(0, 0), cA, voffA); PG8_STAGE(PG8_SA(0, 1), cA + hstepA, voffA);
        if (wr == 1) PG8_BAR;
        PG8_WAIT_V(2); PG8_BAR;
        PG8_STAGE(PG8_SB(1, 0), cB + kstep, voffB); PG8_STAGE(PG8_SA(1, 0), cA + kstep, voffA); PG8_STAGE(PG8_SB(1, 1), cB + hstep + kstep, voffB);
        PG8_WAIT_V(6); PG8_BAR;
    } else {
        PG8_STAGE(PG8_SB(0, 0), cB, voffB); PG8_STAGE(PG8_SA(0, 0), cA, voffA); PG8_STAGE(PG8_SB(0, 1), cB + hstep, voffB); PG8_STAGE(PG8_SA(0, 1), cA + hstepA, voffA);
        if (wr == 1) PG8_BAR;
        PG8_WAIT_V(4); PG8_BAR;
        PG8_STAGE(PG8_SB(1, 0), cB + kstep, voffB); PG8_STAGE(PG8_SA(1, 0), cA + kstep, voffA); PG8_STAGE(PG8_SB(1, 1), cB + hstep + kstep, voffB);
        PG8_WAIT_V(6); PG8_BAR;
    }
    for (;;) {
        const bool has_next = S.next(ui + 1, nxt);
        const char* nA = has_next ? (const char*)g.A + (size_t)nxt.pm * tstepA + (size_t)nxt.pn * astep : cA; const char* nB = has_next ? (const char*)g.Bt + (size_t)nxt.pn * bstep : cB;
        for (int t = 0; t < nt; t += 2) {
            const bool last = (t == nt - 2);
            const char* a1 = cA + (size_t)(t + 1) * kstep;
            const char* a2 = last ? nA : cA + (size_t)(t + 2) * kstep; const char* b2 = last ? nB : cB + (size_t)(t + 2) * kstep;
            const char* a3 = a2 + kstep; const char* b3 = b2 + kstep;
            if (last && has_next) S.a_ready(nxt);
            if (last) E.prefetch(lds + STAGE_BYTES, cur, wr, wid, lane);
            if constexpr (SP2) {
            PG8_LDB(B0, 0, 0); PG8_LDB(B1, 0, 1); PG8_SCHED; PG8_LDA(At, 0, 0); PG8_STAGE(PG8_SA(1, 1), a1 + hstepA, voffA);
            PG8_WAIT_V(8); PG8_WAIT_L(0); PG8_BAR; PG8_MMA(0, 0, At, B0); PG8_MMA(0, 1, At, B1); PG8_BAR; PG8_SCHED;
            PG8_LDA(At, 0, 1); PG8_STAGE(PG8_SB(0, 0), b2, voffB); PG8_STAGE(PG8_SB(0, 1), b2 + hstep, voffB); PG8_STAGE(PG8_SA(0, 0), a2, voffA);
            PG8_WAIT_V(8); PG8_WAIT_L(0); PG8_BAR; PG8_MMA(1, 0, At, B0); PG8_MMA(1, 1, At, B1); PG8_BAR; PG8_SCHED;
            PG8_LDB(B0, 1, 0); PG8_LDB(B1, 1, 1); PG8_SCHED; PG8_LDA(At, 1, 0); PG8_STAGE(PG8_SA(0, 1), a2 + hstepA, voffA);
            PG8_WAIT_V(8); PG8_WAIT_L(0); PG8_BAR; PG8_MMA(0, 0, At, B0); PG8_MMA(0, 1, At, B1); PG8_BAR; PG8_SCHED;
            PG8_LDA(At, 1, 1); PG8_STAGE(PG8_SB(1, 0), b3, voffB); PG8_STAGE(PG8_SB(1, 1), b3 + hstep, voffB); PG8_STAGE(PG8_SA(1, 0), a3, voffA);
            PG8_WAIT_V(8); PG8_WAIT_L(0); PG8_BAR; PG8_MMA(1, 0, At, B0); PG8_MMA(1, 1, At, B1); PG8_BAR; PG8_SCHED;
            } else {
            PG8_LDB(B0, 0, 0); PG8_SCHED; PG8_LDA(At, 0, 0); PG8_STAGE(PG8_SA(1, 1), a1 + hstepA, voffA);
            PG8_WAIT_L(8); PG8_BAR; PG8_WAIT_L(0); PG8_MMA(0, 0, At, B0); PG8_BAR; PG8_SCHED;
            PG8_LDB(B1, 0, 1); PG8_STAGE(PG8_SB(0, 0), b2, voffB);
            PG8_BAR; PG8_WAIT_L(0); PG8_MMA(0, 1, At, B1); PG8_BAR;
            PG8_LDA(At, 0, 1); PG8_STAGE(PG8_SA(0, 0), a2, voffA);
            PG8_BAR; PG8_WAIT_L(0); PG8_MMA(1, 0, At, B0); PG8_BAR; PG8_SCHED;
            PG8_STAGE(PG8_SB(0, 1), b2 + hstep, voffB);
            PG8_WAIT_V(6); PG8_BAR; PG8_MMA(1, 1, At, B1); PG8_BAR;
            PG8_LDB(B0, 1, 0); PG8_SCHED; PG8_LDA(At, 1, 0); PG8_STAGE(PG8_SA(0, 1), a2 + hstepA, voffA);
            PG8_WAIT_L(8); PG8_BAR; PG8_WAIT_L(0); PG8_MMA(0, 0, At, B0); PG8_BAR; PG8_SCHED;
            PG8_LDB(B1, 1, 1); PG8_STAGE(PG8_SB(1, 0), b3, voffB);
            PG8_BAR; PG8_WAIT_L(0); PG8_MMA(0, 1, At, B1); PG8_BAR;
            PG8_LDA(At, 1, 1); PG8_STAGE(PG8_SA(1, 0), a3, voffA);
            PG8_BAR; PG8_WAIT_L(0); PG8_MMA(1, 0, At, B0); PG8_BAR; PG8_SCHED;
            PG8_STAGE(PG8_SB(1, 1), b3 + hstep, voffB);
            PG8_WAIT_V(6); PG8_BAR; PG8_MMA(1, 1, At, B1); PG8_BAR;
            }
        }
        if constexpr (ALIGN_EPI) { if (wr == 0) PG8_BAR; }
        if constexpr (!Epi::AFTER_DRAIN) { E(acc, cur, wr, wc, fr, fq, lds + STAGE_BYTES, wid); S.done(cur); }
        if (!has_next) break;
#pragma unroll
        for (int a = 0; a < 2; ++a)
#pragma unroll
            for (int b = 0; b < 2; ++b)
#pragma unroll
                for (int m = 0; m < 4; ++m)
#pragma unroll
                    for (int n = 0; n < 2; ++n) acc[a][b][m][n] = (f32x4){0.f, 0.f, 0.f, 0.f};
        cur = nxt; cA = nA; cB = nB; ++ui;
        if constexpr (ALIGN_EPI) { if (wr == 1) PG8_BAR; }
    }
    PG8_WAIT_V(0);
    if constexpr (!ALIGN_EPI) { if (wr == 0) PG8_BAR; }
    PG8_BAR;
    if constexpr (Epi::AFTER_DRAIN) { E.fused(acc, cur, wr, wc, fr, fq, lds, wid, lane); S.done(cur); }
#undef PG8_SA
#undef PG8_SB
#undef PG8_STAGE
#undef PG8_LDA
#undef PG8_LDB
#undef PG8_MMA
#undef PG8_WAIT_V
#undef PG8_WAIT_L
#undef PG8_BAR
#undef PG8_SCHED
}
}

#ifndef MK_PER_PHASE
#define MK_PER_PHASE 0
#endif
#define LAS __attribute__((address_space(3)))
typedef unsigned short bf16;
typedef unsigned v4u __attribute__((ext_vector_type(4)));
typedef unsigned v2u __attribute__((ext_vector_type(2)));
typedef float f32x4 __attribute__((ext_vector_type(4)));
typedef float f32x2v __attribute__((ext_vector_type(2)));
typedef short bf16x8 __attribute__((ext_vector_type(8)));
typedef short s16x4 __attribute__((ext_vector_type(4)));
typedef float f32x16 __attribute__((ext_vector_type(16)));

__device__ __forceinline__ float wave_sum(float v) {
#pragma unroll
    for (int o = 1; o < 64; o <<= 1) v += __shfl_xor(v, o);
    return v;
}
__device__ __forceinline__ unsigned pk2(float lo, float hi) { return pg8::cvt_pk_bf16(lo, hi); }
__device__ __forceinline__ float bflo(unsigned w) { return __uint_as_float(w << 16); }
__device__ __forceinline__ float bfhi(unsigned w) { return __uint_as_float(w & 0xffff0000u); }

__device__ __forceinline__ void transpose_item(const float* W, int K, int N, bf16* WT, int mode, float scale, const float* kgain, LAS float* scr, int item, int lane) {
    const int nblk = N / 64, kb = item / nblk, nb = item % nblk, k0 = 64 * kb, n0 = 64 * nb;
    int drow0 = n0;
    if (mode == 1) { const int half = (n0 >= FF) ? 1 : 0; const int j = n0 - half * FF; drow0 = (j >> 7) * 256 + half * 128 + (j & 127); }
    f32x2v v[32];
    const float* src = W + (size_t)(k0 + (lane >> 5)) * N + n0 + 2 * (lane & 31);
#pragma unroll
    for (int i = 0; i < 32; ++i) v[i] = __builtin_nontemporal_load((const f32x2v*)(src + (size_t)(2 * i) * N));
#pragma unroll
    for (int i = 0; i < 32; ++i) { LAS float* d = scr + (2 * i + (lane >> 5)) * 65 + 2 * (lane & 31); d[0] = v[i].x; d[1] = v[i].y; }
    asm volatile("s_waitcnt lgkmcnt(0)" ::: "memory");
    const int c = lane & 7;
    f32x4 g0 = (f32x4){scale, scale, scale, scale}, g1 = g0;
    if (kgain) { g0 = *(const f32x4*)(kgain + k0 + 8 * c) * scale; g1 = *(const f32x4*)(kgain + k0 + 8 * c + 4) * scale; }
#pragma unroll
    for (int j = 0; j < 8; ++j) { const int n = (lane >> 3) + 8 * j; const LAS float* s = scr + (8 * c) * 65 + n;
        v4u o; o.x = pk2(s[0 * 65] * g0.x, s[1 * 65] * g0.y); o.y = pk2(s[2 * 65] * g0.z, s[3 * 65] * g0.w); o.z = pk2(s[4 * 65] * g1.x, s[5 * 65] * g1.y); o.w = pk2(s[6 * 65] * g1.z, s[7 * 65] * g1.w);
        *(v4u*)(WT + (size_t)(drow0 + n) * K + k0 + 8 * c) = o; }
    asm volatile("s_waitcnt lgkmcnt(0)" ::: "memory");
}
__device__ __forceinline__ void transpose_matrix(const float* W, int K, int N, bf16* WT, int mode, float scale, const float* kgain, LAS float* scr, int gw, int NGW, int lane) {
    const int items = (K / 64) * (N / 64);
    for (int it = gw; it < items; it += NGW) transpose_item(W, K, N, WT, mode, scale, kgain, scr, it, lane);
}

__device__ __forceinline__ void row_bf16_ss(const float* xrow, bf16* orow, u64_t* ss_out, int lane) {
    const f32x4* xr = (const f32x4*)xrow + lane;
    f32x4 v[8]; float s = 0.f;
#pragma unroll
    for (int j = 0; j < 8; ++j) { v[j] = xr[64 * j]; s += (v[j].x * v[j].x + v[j].y * v[j].y) + (v[j].z * v[j].z + v[j].w * v[j].w); }
    s = wave_sum(s);
    v2u* o8 = (v2u*)orow + lane;
#pragma unroll
    for (int j = 0; j < 8; ++j) { v2u o; o.x = pk2(v[j].x, v[j].y); o.y = pk2(v[j].z, v[j].w); o8[64 * j] = o; }
    if (lane == 0) *ss_out = (u64_t)__float2ll_rn(s * 16777216.0f);
}
__device__ __forceinline__ void rms_row_out(const bf16* xrow, const float* g, float ss, float* orow, int lane) {
    const float rstd = 1.0f / sqrtf(ss * (1.f / DM) + EPS);
    const v4u* xr = (const v4u*)xrow + lane; const f32x4* gr = (const f32x4*)g + 2 * lane; f32x4* o = (f32x4*)orow + 2 * lane;
    v4u w[4];
#pragma unroll
    for (int j = 0; j < 4; ++j) w[j] = xr[64 * j];
#pragma unroll
    for (int j = 0; j < 4; ++j) { const f32x4 g0 = gr[128 * j], g1 = gr[128 * j + 1];
        o[128 * j] = (f32x4){bflo(w[j].x) * rstd * g0.x, bfhi(w[j].x) * rstd * g0.y, bflo(w[j].y) * rstd * g0.z, bfhi(w[j].y) * rstd * g0.w};
        o[128 * j + 1] = (f32x4){bflo(w[j].z) * rstd * g1.x, bfhi(w[j].z) * rstd * g1.y, bflo(w[j].w) * rstd * g1.z, bfhi(w[j].w) * rstd * g1.w}; }
}

__device__ __forceinline__ void sgu_spatial_phase(LAS unsigned char* lds, const bf16* U, bf16* GO, const bf16* V, const u64_t* vsum, const u64_t* vsq, const float* gain, const float* bias, const float* wsp, const float* bsp, int G, int bx) {
    constexpr int P = 272, VTB = 128 * P;
    LAS unsigned char* WsL = lds; LAS float* GB = (LAS float*)(lds + 3 * VTB);
    int tid_ = threadIdx.x; asm volatile("" : "+v"(tid_));
    const int tid = tid_, lane = tid & 63, fr = lane & 15, fq = lane >> 4; const int wid = __builtin_amdgcn_readfirstlane(tid >> 6);
    const int cc = tid & 15, jp = tid >> 4;
    const int nunits = bx < 1024 ? (1024 - bx + G - 1) / G : 0, nch = 4 * nunits;
    const int i0 = wid * 16; const int nks = (i0 < 64) ? 2 : 4;
    v4u vr[2][4], ur[2][4]; f32x2v sr[2][4];
    int cur_g = -1; float bsv = 0.f;
#define SP_COORD(t) const int u_ = bx + ((t) >> 2) * G, g_ = u_ & 7, nb_ = u_ >> 3, chunk_ = (t) & 3; const size_t row0_ = (size_t)nb_ * 128; const int cbase_ = g_ * 512 + chunk_ * 128;
#define SP_LOAD(slot, t) do { SP_COORD(t) \
        _Pragma("unroll") for (int hs_ = 0; hs_ < 4; ++hs_) { const size_t r_ = row0_ + 64 * (hs_ >> 1) + 2 * jp + (hs_ & 1); vr[slot][hs_] = *(const v4u*)(V + r_ * SW + cbase_ + cc * 8); { const float mu_ = stat_get(vsum[r_]) * (1.f / SW); sr[slot][hs_] = (f32x2v){mu_, 1.0f / sqrtf(fmaxf(stat_get(vsq[r_]) * (1.f / SW) - mu_ * mu_, 0.f) + EPS)}; } } \
        _Pragma("unroll") for (int c4_ = 0; c4_ < 4; ++c4_) ur[slot][c4_] = *(const v4u*)(U + (row0_ + i0 + fr) * SW + cbase_ + c4_ * 32 + 8 * fq); } while (0)
#define SP_STEP(slot, t, buf) do { SP_COORD(t) \
        if (chunk_ == 0 && g_ != cur_g) { __syncthreads(); \
            _Pragma("unroll") for (int i_ = 0; i_ < 8; ++i_) { const int e4 = tid + 512 * i_; f32x4 w = *(const f32x4*)(wsp + (size_t)g_ * 16384 + (size_t)e4 * 4); const int row = e4 >> 5, j = (e4 & 31) * 4; \
                if ((row >> 6) < (j >> 6)) w = (f32x4){0.f, 0.f, 0.f, 0.f}; \
                *(LAS v2u*)(WsL + row * P + j * 2) = (v2u){pk2(w.x, w.y), pk2(w.z, w.w)}; } \
            GB[tid] = gain[g_ * 512 + tid]; GB[512 + tid] = bias[g_ * 512 + tid]; bsv = bsp[g_ * 128 + i0 + fr]; cur_g = g_; __syncthreads(); } \
        LAS unsigned char* VTb = lds + (1 + (buf)) * VTB; \
        { const int lc = chunk_ * 128 + cc * 8; \
          const f32x4 ga0 = *(const LAS f32x4*)(GB + lc), ga1 = *(const LAS f32x4*)(GB + lc + 4), bi0 = *(const LAS f32x4*)(GB + 512 + lc), bi1 = *(const LAS f32x4*)(GB + 512 + lc + 4); \
          _Pragma("unroll") for (int half = 0; half < 2; ++half) { const int j = 64 * half + 2 * jp; const v4u w0 = vr[slot][2 * half], w1 = vr[slot][2 * half + 1]; const f32x2v s0 = sr[slot][2 * half], s1 = sr[slot][2 * half + 1]; \
              const int cofs = (((j >> 3) ^ cc) << 4) + (j & 7) * 2; \
              _Pragma("unroll") for (int e = 0; e < 4; ++e) { const float gA = e < 2 ? ga0[2 * e] : ga1[2 * e - 4], gB = e < 2 ? ga0[2 * e + 1] : ga1[2 * e - 3], bA = e < 2 ? bi0[2 * e] : bi1[2 * e - 4], bB = e < 2 ? bi0[2 * e + 1] : bi1[2 * e - 3]; \
                  const float y0a = (bflo(w0[e]) - s0.x) * s0.y * gA + bA, y1a = (bflo(w1[e]) - s1.x) * s1.y * gA + bA; \
                  const float y0b = (bfhi(w0[e]) - s0.x) * s0.y * gB + bB, y1b = (bfhi(w1[e]) - s1.x) * s1.y * gB + bB; \
                  *(LAS unsigned*)(VTb + (cc * 8 + 2 * e) * P + cofs) = pk2(y0a, y1a); \
                  *(LAS unsigned*)(VTb + (cc * 8 + 2 * e + 1) * P + cofs) = pk2(y0b, y1b); } } } \
        __syncthreads(); \
        bf16x8 wf[4]; \
        _Pragma("unroll") for (int ks = 0; ks < 4; ++ks) wf[ks] = *(const LAS bf16x8*)(WsL + (i0 + fr) * P + (32 * ks + 8 * fq) * 2); \
        _Pragma("unroll") for (int c4 = 0; c4 < 4; ++c4) { \
            f32x4 acc[2]; \
            _Pragma("unroll") for (int n = 0; n < 2; ++n) { acc[n] = (f32x4){0.f, 0.f, 0.f, 0.f}; const int vrow = c4 * 32 + 8 * (fr >> 2) + 4 * n + (fr & 3); const int sw = (vrow >> 3) & 15; \
                _Pragma("unroll") for (int ks = 0; ks < 4; ++ks) if (ks < nks) { const bf16x8 vf = *(const LAS bf16x8*)(VTb + vrow * P + (((4 * ks + fq) ^ sw) << 4)); acc[n] = __builtin_amdgcn_mfma_f32_16x16x32_bf16(vf, wf[ks], acc[n], 0, 0, 0); } } \
            bf16* up = GO + (row0_ + i0 + fr) * SW + cbase_ + c4 * 32 + 8 * fq; \
            const v4u uw = ur[slot][c4]; v4u o; \
            o.x = pk2(bflo(uw.x) * (acc[0][0] + bsv), bfhi(uw.x) * (acc[0][1] + bsv)); o.y = pk2(bflo(uw.y) * (acc[0][2] + bsv), bfhi(uw.y) * (acc[0][3] + bsv)); \
            o.z = pk2(bflo(uw.z) * (acc[1][0] + bsv), bfhi(uw.z) * (acc[1][1] + bsv)); o.w = pk2(bflo(uw.w) * (acc[1][2] + bsv), bfhi(uw.w) * (acc[1][3] + bsv)); \
            *(v4u*)up = o; } \
        if ((t) + 2 < nch) SP_LOAD(slot, (t) + 2); } while (0)
    if (nch > 0) { SP_LOAD(0, 0); SP_LOAD(1, 1); }
    for (int t = 0; t < nch; t += 2) { SP_STEP(0, t, 0); SP_STEP(1, t + 1, 1); }
    __syncthreads();
#undef SP_COORD
#undef SP_LOAD
#undef SP_STEP
}

__device__ __forceinline__ int crow(int r, int hi) { return (r & 3) + 8 * (r >> 2) + 4 * hi; }
__device__ __forceinline__ float att_max3(float a, float b, float c) { float r; asm("v_max3_f32 %0, %1, %2, %3" : "=v"(r) : "v"(a), "v"(b), "v"(c)); return r; }
__device__ __forceinline__ float att_max2(float a, float b) { float r; asm("v_max_f32_e32 %0, %1, %2" : "=v"(r) : "v"(a), "v"(b)); return r; }
__device__ __forceinline__ void attn_unit(int b, int h, int qb, const bf16* Q, const bf16* KV, const bf16* KR, const f32x2v* tab, bf16* O, LAS unsigned char* lds) {
    constexpr int KP = 400, KBUF = 64 * KP, VBUF = 16384, VOFF = 2 * KBUF, WSF_OFF = VOFF + 3 * VBUF;
    int tid_ = threadIdx.x; asm volatile("" : "+v"(tid_));
    const int tid = tid_, lane = tid & 63, r32 = lane & 31, hi = lane >> 5; const int wid = __builtin_amdgcn_readfirstlane(tid >> 6);
    const size_t rowbase = (size_t)b * SEQ; const int q0 = qb * 256;
    const int NT = 4 * qb + 4, my_last = 4 * qb + (wid >> 1);
    LAS float* wsf = (LAS float*)(lds + WSF_OFF) + wid * 64;
    const bf16* ksrc[4]; const bf16* vsrc[2]; long kstep[4];
#pragma unroll
    for (int j = 0; j < 4; ++j) { const int off = (wid + 8 * j) * 1024 + lane * 16, row = (off / KP) & 63; int c = (off % KP) >> 4; if (c >= 24) c = 0;
        if (c < 16) { ksrc[j] = KV + (rowbase + row) * KVUP_N + h * 256 + c * 8; kstep[j] = 64L * KVUP_N; } else { ksrc[j] = KR + (rowbase + row) * 64 + (c - 16) * 8; kstep[j] = 64L * 64; } }
#pragma unroll
    for (int j = 0; j < 2; ++j) { const int off = (wid + 8 * j) * 1024 + lane * 16, cblk = off >> 12, rem = off & 4095, kv = (rem >> 9) * 8 + ((rem & 511) >> 6), d = cblk * 32 + ((rem & 63) >> 4) * 8;
        vsrc[j] = KV + (rowbase + kv) * KVUP_N + h * 256 + 128 + d; }
#define ATT_DMA(kt, kb, vb) do { \
        _Pragma("unroll") for (int j_ = 0; j_ < 3; ++j_) __builtin_amdgcn_global_load_lds((const unsigned*)(ksrc[j_] + (long)(kt) * kstep[j_]), (LAS unsigned*)(lds + (kb) * KBUF + (wid + 8 * j_) * 1024), 16, 0, 0); \
        if (wid == 0) __builtin_amdgcn_global_load_lds((const unsigned*)(ksrc[3] + (long)(kt) * kstep[3]), (LAS unsigned*)(lds + (kb) * KBUF + 24 * 1024), 16, 0, 0); \
        _Pragma("unroll") for (int j_ = 0; j_ < 2; ++j_) __builtin_amdgcn_global_load_lds((const unsigned*)(vsrc[j_] + (long)(kt) * 64L * KVUP_N), (LAS unsigned*)(lds + VOFF + (vb) * VBUF + (wid + 8 * j_) * 1024), 16, 0, 0); } while (0)
    ATT_DMA(0, 0, 0);
    const size_t qrow = rowbase + q0 + wid * 32 + r32;
    const bf16* Qp = Q + qrow * QUP_N + h * QKD + hi * 8;
    v4u qr[12];
#pragma unroll
    for (int d0 = 0; d0 < 12; ++d0) qr[d0] = *(const v4u*)(Qp + d0 * 16);
#pragma unroll
    for (int dd = 0; dd < 2; ++dd) { const f32x4* cs = (const f32x4*)(tab + qrow * 32 + 16 * dd + 8 * hi);
#pragma unroll
        for (int jj = 0; jj < 4; ++jj) { const f32x4 t = cs[jj]; const unsigned a = qr[8 + dd][jj], c = qr[10 + dd][jj];
            const float x1l = bflo(a), x1h = bfhi(a), x2l = bflo(c), x2h = bfhi(c);
            qr[8 + dd][jj] = pk2(x1l * t.x - x2l * t.y, x1h * t.z - x2h * t.w);
            qr[10 + dd][jj] = pk2(x1l * t.y + x2l * t.x, x1h * t.w + x2h * t.z); } }
    float mhat = 0.f, lsum = 0.f; f32x16 o[4];
#pragma unroll
    for (int c = 0; c < 4; ++c)
#pragma unroll
        for (int r = 0; r < 16; ++r) o[c][r] = 0.f;
    asm volatile("s_waitcnt vmcnt(0)" ::: "memory");
    __syncthreads();
    v4u pw[4];
#pragma unroll
    for (int i = 0; i < 4; ++i) pw[i] = (v4u){0u, 0u, 0u, 0u};
    int vprev = 0, vcur = 0, vnext = 1;
    const int vlane = (4 * hi + ((lane & 15) >> 2)) * 64 + ((lane >> 4) & 1) * 32 + (lane & 3) * 8;
#define TRD(p) __builtin_bit_cast(s16x4, __builtin_amdgcn_ds_read_tr16_b64_v4i16((LAS s16x4*)(p)))
#define ATT_VRD(i, dst) do { const LAS unsigned char* q_ = vp + ((i) >> 1) * 4096 + (2 * ((i) & 1)) * 1024; dst[0] = TRD(q_); dst[1] = TRD(q_ + 512); dst[2] = TRD(q_ + 1024); dst[3] = TRD(q_ + 1536); } while (0)
#define ATT_CAT(a, b) ((bf16x8){a[0], a[1], a[2], a[3], b[0], b[1], b[2], b[3]})
#define ATT_PVM(i, src) do { o[(i) >> 1] = __builtin_amdgcn_mfma_f32_32x32x16_bf16(__builtin_bit_cast(bf16x8, pw[2 * ((i) & 1)]), ATT_CAT(src[0], src[1]), o[(i) >> 1], 0, 0, 0); \
                              o[(i) >> 1] = __builtin_amdgcn_mfma_f32_32x32x16_bf16(__builtin_bit_cast(bf16x8, pw[2 * ((i) & 1) + 1]), ATT_CAT(src[2], src[3]), o[(i) >> 1], 0, 0, 0); } while (0)
#define ATT_SMC(i) do { if ((i) < 4) { _Pragma("unroll") for (int r = 4 * (i); r < 4 * (i) + 4; ++r) { p0[r] = __builtin_amdgcn_exp2f(p0[r]); sacc += p0[r]; } \
                                      if ((i) & 1) { const int k_ = (i) >> 1; _Pragma("unroll") for (int w = 0; w < 4; ++w) pn[k_][w] = pk2(p0[8 * k_ + 2 * w], p0[8 * k_ + 2 * w + 1]); } } \
                        else { _Pragma("unroll") for (int r = 4 * ((i) - 4); r < 4 * ((i) - 4) + 4; ++r) { p1[r] = __builtin_amdgcn_exp2f(p1[r]); sacc += p1[r]; } \
                               if ((i) & 1) { const int k_ = ((i) - 4) >> 1; _Pragma("unroll") for (int w = 0; w < 4; ++w) pn[2 + k_][w] = pk2(p1[8 * k_ + 2 * w], p1[8 * k_ + 2 * w + 1]); } } } while (0)
#define ATT_MIX(DO_PV, DO_SM) do { const LAS unsigned char* vp = lds + VOFF + vprev * VBUF + vlane; s16x4 va[4], vb[4]; float sacc = 0.f; \
        if (DO_PV) ATT_VRD(0, va); \
        _Pragma("unroll") for (int i = 0; i < 8; ++i) { \
            if (DO_PV && i + 1 < 8) { if (i & 1) ATT_VRD(i + 1, va); else ATT_VRD(i + 1, vb); } \
            __builtin_amdgcn_sched_barrier(0); \
            if (DO_PV) { __builtin_amdgcn_s_setprio(1); if (i & 1) ATT_PVM(i, vb); else ATT_PVM(i, va); __builtin_amdgcn_s_setprio(0); } \
            if (DO_SM) ATT_SMC(i); \
            __builtin_amdgcn_sched_barrier(0); } \
        if (DO_SM) lsum += sacc; } while (0)
    for (int t = 0; t < NT; ++t) {
        if (t + 1 < NT) ATT_DMA(t + 1, (t + 1) & 1, vnext);
        const bool do_qk = (t <= my_last);
        f32x16 p0, p1; bool resc = false; v4u pn[4];
        if (do_qk) {
            const LAS unsigned char* Kb = lds + (t & 1) * KBUF + r32 * KP; const int ksw = r32 & 7;
            { const float nm = -mhat;
#pragma unroll
              for (int r = 0; r < 16; ++r) { p0[r] = nm; p1[r] = nm; } }
            bf16x8 kf[6][4];
#define KOF(d0) ((2 * (d0) + hi) * 16)
#define KLD(g) do { kf[g][0] = *(const LAS bf16x8*)(Kb + KOF(2 * (g))); kf[g][1] = *(const LAS bf16x8*)(Kb + 32 * KP + KOF(2 * (g))); \
                    kf[g][2] = *(const LAS bf16x8*)(Kb + KOF(2 * (g) + 1)); kf[g][3] = *(const LAS bf16x8*)(Kb + 32 * KP + KOF(2 * (g) + 1)); } while (0)
            KLD(0);
#pragma unroll
            for (int g = 0; g < 6; ++g) {
                if (g + 1 < 6) KLD(g + 1);
                __builtin_amdgcn_sched_barrier(0);
                const bf16x8 qa = __builtin_bit_cast(bf16x8, qr[2 * g]), qb_ = __builtin_bit_cast(bf16x8, qr[2 * g + 1]);
                __builtin_amdgcn_s_setprio(1);
                p0 = __builtin_amdgcn_mfma_f32_32x32x16_bf16(kf[g][0], qa, p0, 0, 0, 0); p1 = __builtin_amdgcn_mfma_f32_32x32x16_bf16(kf[g][1], qa, p1, 0, 0, 0);
                p0 = __builtin_amdgcn_mfma_f32_32x32x16_bf16(kf[g][2], qb_, p0, 0, 0, 0); p1 = __builtin_amdgcn_mfma_f32_32x32x16_bf16(kf[g][3], qb_, p1, 0, 0, 0);
                __builtin_amdgcn_s_setprio(0);
                __builtin_amdgcn_sched_barrier(0);
            }
#undef KLD
#undef KOF
            asm volatile("s_nop 15\n\ts_nop 7" : "+v"(p0), "+v"(p1));
            float rm;
            { float a = att_max3(p0[0], p0[1], p1[0]), b = att_max3(p0[2], p0[3], p1[1]); a = att_max3(a, p1[2], p1[3]);
#pragma unroll
              for (int r = 4; r < 16; r += 4) { a = att_max3(a, p0[r], p0[r + 1]); b = att_max3(b, p0[r + 2], p0[r + 3]); a = att_max3(a, p1[r], p1[r + 1]); b = att_max3(b, p1[r + 2], p1[r + 3]); }
              rm = att_max2(a, b); }
            { auto rr = __builtin_amdgcn_permlane32_swap(__float_as_uint(rm), __float_as_uint(rm), false, false); rm = att_max2(__uint_as_float(rr[0]), __uint_as_float(rr[1])); }
            const bool first = (t == 0);
            if (first || __any(rm > 8.0f)) {
                const float dl = first ? rm : fmaxf(rm, 0.f);
                mhat += dl;
#pragma unroll
                for (int r = 0; r < 16; ++r) { p0[r] -= dl; p1[r] -= dl; }
                if (!first) { const float f = __builtin_amdgcn_exp2f(-dl); lsum *= f; if (hi == 0) wsf[r32] = f; resc = true; }
            }
        }
        __builtin_amdgcn_sched_barrier(0);
        if (do_qk) {
            vprev = vcur;
            ATT_MIX(false, true);
            if (resc) {
#pragma unroll
                for (int r = 0; r < 16; ++r) { const float fr_ = wsf[crow(r, hi)];
#pragma unroll
                    for (int c = 0; c < 4; ++c) o[c][r] *= fr_; }
            }
#pragma unroll
            for (int i = 0; i < 4; ++i) pw[i] = pn[i];
            ATT_MIX(true, false);
        }
        asm volatile("s_waitcnt vmcnt(0)" ::: "memory");
        __syncthreads();
        vprev = vcur; vcur = vnext; vnext = (vnext == 2) ? 0 : vnext + 1;
    }
#undef ATT_MIX
#undef ATT_SMC
#undef ATT_PVM
#undef ATT_CAT
#undef ATT_VRD
#undef TRD
    { auto rr = __builtin_amdgcn_permlane32_swap(__float_as_uint(lsum), __float_as_uint(lsum), false, false); lsum = __uint_as_float(rr[0]) + __uint_as_float(rr[1]); }
    if (hi == 0) wsf[32 + r32] = lsum;
    bf16* Ow = O + (rowbase + q0 + wid * 32) * DM + h * 128 + r32;
#pragma unroll
    for (int r = 0; r < 16; ++r) { const int orow = crow(r, hi); const float rl = __builtin_amdgcn_rcpf(wsf[32 + orow]);
#pragma unroll
        for (int c = 0; c < 4; c += 1) { const unsigned w = pk2(o[c][r] * rl, 0.f); Ow[(size_t)orow * DM + 32 * c] = (bf16)(w & 0xffffu); } }
#undef ATT_DMA
}
__device__ __forceinline__ void attn_phase(LAS unsigned char* lds, const bf16* Q, const bf16* KV, const bf16* KR, const f32x2v* tab, bf16* O, int G, int bx) {
    for (int i = 0;; ++i) { const int idx = i * G + bx; if (idx >= 1024) break;
        const int i4 = idx >> 8, v0 = idx & 255, v = (v0 & 7) * 32 + (v0 >> 3), bh = v >> 3, s = v & 7;
        const int qb = i4 == 0 ? 31 - s : i4 == 1 ? 16 + s : i4 == 2 ? 15 - s : s;
        attn_unit(bh >> 4, bh & 15, qb, Q, KV, KR, tab, O, lds); }
}

typedef GAS unsigned gu32;
#define XB_TMO      128
#define XB_XCNT(j)  (256  + 64 * (j))
#define XB_XSUB(j)  (1280 + 64 * (j))
#define XB_XGEN(j)  (2304 + 64 * (j))
#define XB_TOP      3328
#define XB_TOPGEN   3392
#define XCD_BAR_WORDS 3456
#define XB_SPIN_CAP (1u << 18)

__device__ __forceinline__ unsigned xb_ld(unsigned* p)              { return __hip_atomic_load(p, __ATOMIC_RELAXED, __HIP_MEMORY_SCOPE_AGENT); }
__device__ __forceinline__ unsigned xb_add(unsigned* p, unsigned v) { return __hip_atomic_fetch_add(p, v, __ATOMIC_RELAXED, __HIP_MEMORY_SCOPE_AGENT); }
__device__ __forceinline__ unsigned xb_xcc_id() { return (unsigned)__builtin_amdgcn_s_getreg((3 << 11) | 20) & 0xFu; }
#define XB_SPIN(cond, bar) do { unsigned _sp = 0; while (cond) { __builtin_amdgcn_s_sleep(1); \
    if ((++_sp & 255u) == 0u) { if (xb_ld(&(bar)[XB_TMO])) break; if (_sp > XB_SPIN_CAP) { atomicAdd(&(bar)[XB_TMO], 1u); break; } } } } while (0)

struct XcdBarrier {
    unsigned* bar; unsigned x;
    volatile LAS unsigned* st;
};

__device__ __forceinline__ XcdBarrier xcd_barrier_post(unsigned* bar, volatile LAS unsigned* st) {
    XcdBarrier b; b.bar = bar; b.x = xb_xcc_id(); b.st = st;
    if (threadIdx.x == 0) (void)xb_add(&bar[XB_XCNT(b.x)], 1u);
    return b;
}
__device__ __forceinline__ void xcd_barrier_complete(unsigned* bar, unsigned x, unsigned& nloc, unsigned& nx) {
    const unsigned G = gridDim.x * gridDim.y * gridDim.z;
    unsigned sum, cnt, mine, sp = 0u;
    for (;;) {
        sum = 0u; cnt = 0u; mine = 0u;
#pragma unroll
        for (unsigned j = 0; j < 16; ++j) { const unsigned c = xb_ld(&bar[XB_XCNT(j)]); sum += c; cnt += (c > 0u) ? 1u : 0u; mine = (j == x) ? c : mine; }
        if (sum == G) break;
        __builtin_amdgcn_s_sleep(1);
        if ((++sp & 255u) == 0u) { if (xb_ld(&bar[XB_TMO])) break; if (sp > XB_SPIN_CAP) { atomicAdd(&bar[XB_TMO], 1u); break; } }
    }
    nloc = mine > 0u ? mine : 1u; nx = cnt > 0u ? cnt : 1u;
}

__device__ __forceinline__ void xcd_barrier(const XcdBarrier& b) {
    asm volatile("s_waitcnt vmcnt(0)" ::: "memory");
    __syncthreads();
    if (threadIdx.x == 0) {
        unsigned* bar = b.bar;
        __builtin_amdgcn_s_waitcnt(0);
        unsigned nloc = b.st[0], nx = b.st[1];
        if (nloc == 0u) { xcd_barrier_complete(bar, b.x, nloc, nx); b.st[0] = nloc; b.st[1] = nx; }
        const unsigned old = xb_add(&bar[XB_XSUB(b.x)], 1u);
        const unsigned gen = old / nloc;
        if (old + 1u == (gen + 1u) * nloc) {
            __builtin_amdgcn_fence(__ATOMIC_RELEASE, "agent");
            asm volatile("s_waitcnt vmcnt(0)" ::: "memory");
            const unsigned og = xb_add(&bar[XB_TOP], 1u);
            const unsigned tg = og / nx;
            if (og + 1u == (tg + 1u) * nx) xb_add(&bar[XB_TOPGEN], 1u);
            else XB_SPIN(xb_ld(&bar[XB_TOPGEN]) == tg, bar);
            __builtin_amdgcn_fence(__ATOMIC_ACQUIRE, "agent");
            xb_add(&bar[XB_XGEN(b.x)], 1u);
            asm volatile("s_waitcnt vmcnt(0)" ::: "memory");
        } else {
            XB_SPIN(xb_ld(&bar[XB_XGEN(b.x)]) == gen, bar);
            __builtin_amdgcn_fence(__ATOMIC_ACQUIRE, "agent");
            asm volatile("s_waitcnt vmcnt(0)" ::: "memory");
        }
    }
    __syncthreads();
}

#define GRP_BAR_WORD0 3584
__device__ __forceinline__ void grp_barrier(unsigned* words, int grp, unsigned nblk) {
    asm volatile("s_waitcnt vmcnt(0)" ::: "memory");
    __syncthreads();
    if (threadIdx.x == 0) {
        __builtin_amdgcn_fence(__ATOMIC_RELEASE, "agent");
        asm volatile("s_waitcnt vmcnt(0)" ::: "memory");
        unsigned* c = words + GRP_BAR_WORD0 + 64 * grp;
        const unsigned old = xb_add(c, 1u), target = (old / nblk + 1u) * nblk;
        unsigned sp = 0u;
        while (xb_ld(c) < target) { __builtin_amdgcn_s_sleep(1); if (++sp > (1u << 22)) break; }
        __builtin_amdgcn_fence(__ATOMIC_ACQUIRE, "agent");
        asm volatile("s_waitcnt vmcnt(0)" ::: "memory");
    }
    __syncthreads();
}
#ifndef GRP_SEAM_MASK
#define GRP_SEAM_MASK ((1u << 1) | (1u << 6) | (1u << 7) | (1u << 8) | (1u << 9) | (1u << 13) | (1u << 14))
#endif

struct Args { const void* in[22]; float* out; unsigned char* ws; int ph_lo, ph_hi, coop, pad; };
constexpr int NPHASES = 17;

__global__ void __launch_bounds__(NTHR, 2) mk_fwd(Args a) {
    extern __shared__ __attribute__((aligned(16))) unsigned char lds_raw[];
    LAS unsigned char* lds = (LAS unsigned char*)lds_raw;
    cg::grid_group grid = cg::this_grid();
    const int G = gridDim.x;
#define NGW (G * NWAVES)
    const int ph_lo = KARG_INT(0), ph_hi = KARG_INT(1), coop = KARG_INT(2);
    int ph = 0;
#ifndef DUP_MASK
#define DUP_MASK 0u
#endif
    volatile LAS unsigned* bar_st = (volatile LAS unsigned*)(lds + 147456 - 64);
    if (threadIdx.x < 2) bar_st[threadIdx.x] = 0u;
    __syncthreads();
    XcdBarrier xbar; xbar.bar = (unsigned*)WS_P; xbar.x = 0; xbar.st = bar_st;
    bool bar_ready = false;
#define BEGIN_PHASE if (ph_lo <= ph && ph < ph_hi) { for (int rep_ = 0; rep_ < ((((unsigned)DUP_MASK >> ph) & 1u) ? 2 : 1); ++rep_) { unsigned char* ws = WS_P; float* out = OUT_P; bf16* XN = (bf16*)(ws + WS_XN); bf16* BIG = (bf16*)(ws + WS_BIG); f32x2v* TAB = (f32x2v*)(ws + WS_ROPE); int tid_ = threadIdx.x, bx_ = blockIdx.x; asm volatile("" : "+v"(tid_), "+s"(bx_)); const int tid = tid_, bx = bx_, lane = tid & 63, wave = __builtin_amdgcn_readfirstlane(tid >> 6), gw = bx * NWAVES + wave; (void)bx; (void)out; (void)XN; (void)BIG; (void)TAB; (void)lane; (void)tid; (void)wave; (void)gw;
#define END_PHASE } if (coop && ph + 1 < ph_hi) { if (!bar_ready) { grid.sync(); xbar = xcd_barrier_post((unsigned*)WS_P, bar_st); bar_ready = true; } else if (((unsigned)GRP_SEAM_MASK >> ph) & 1u & (unsigned)((G & 7) == 0)) { grp_barrier((unsigned*)WS_P, (int)(blockIdx.x & 7), (unsigned)G >> 3); } else { xbar.bar = (unsigned*)WS_P; xcd_barrier(xbar); } } } ++ph;

    BEGIN_PHASE
        if (bx == 0) for (int i = tid; i < 4096; i += NTHR) ((unsigned*)ws)[i] = 0u;
        { v4u* z = (v4u*)(ws + WS_RSS + RSS_SZ); const int nz = (int)((WS_STAT_END - WS_RSS - RSS_SZ) / 16);
          for (int i = bx * NTHR + tid; i < nz; i += G * NTHR) z[i] = (v4u){0u, 0u, 0u, 0u}; }
        { const float* x_in = IN_F(0); u64_t* rss0 = (u64_t*)(ws + WS_RSS);
          for (int m = gw; m < M; m += NGW) row_bf16_ss(x_in + (size_t)m * DM, XN + (size_t)m * DM, rss0 + m, lane); }
        LAS float* scr = (LAS float*)(lds + wave * 16640);
        for (int i = 0; i < 2; ++i) for (int w = 0; w < 2; ++w) {
            transpose_matrix((w ? IN_F(7) : IN_F(3)) + (size_t)i * DM * 2 * FF, DM, 2 * FF, (bf16*)(ws + WS_WFI + (size_t)(2 * i + w) * WFI_SZ), 1, 1.f, (w ? IN_F(6) : IN_F(2)) + i * DM, scr, gw, NGW, lane);
            transpose_matrix((w ? IN_F(8) : IN_F(4)) + (size_t)i * FF * DM, FF, DM, (bf16*)(ws + WS_WFO + (size_t)(2 * i + w) * WFO_SZ), 0, 1.f, nullptr, scr, gw, NGW, lane);
        }
        transpose_matrix(IN_F(9), DM, 2 * SW, (bf16*)(ws + WS_WSI), 0, 1.f, IN_F(5), scr, gw, NGW, lane);
        transpose_matrix(IN_F(14), SW, DM, (bf16*)(ws + WS_WSO), 0, 1.f, nullptr, scr, gw, NGW, lane);
        transpose_matrix(IN_F(15), DM, MLA_IN, (bf16*)(ws + WS_WMI), 0, 1.f, IN_F(5) + DM, scr, gw, NGW, lane);
        transpose_matrix(IN_F(17), 512, QUP_N, (bf16*)(ws + WS_WQU), 0, C2, IN_F(16), scr, gw, NGW, lane);
        transpose_matrix(IN_F(19), 512, KVUP_N, (bf16*)(ws + WS_WKV), 0, 1.f, IN_F(18), scr, gw, NGW, lane);
        transpose_matrix(IN_F(20), DM, DM, (bf16*)(ws + WS_WMO), 0, 1.f, nullptr, scr, gw, NGW, lane);
        { v4u* padp = (v4u*)(ws + WS_WMI + (size_t)MLA_IN * DM * 2); const int npad = (MLA_INP - MLA_IN) * DM * 2 / 16;
          for (int i = bx * NTHR + tid; i < npad; i += G * NTHR) padp[i] = (v4u){0u, 0u, 0u, 0u}; }
        for (int idx = bx * NTHR + tid; idx < M * 32; idx += G * NTHR) { const int m = idx >> 5, f = idx & 31;
            const float inv = __builtin_amdgcn_exp2f(-(float)f * (13.287712379549449f / 32.f)); const float ang = (float)((const int*)KARG_PTR(1))[m] * inv;
            double rev = (double)ang * 0.15915494309189535; rev -= __builtin_rint(rev); const float fr = (float)rev;
            TAB[idx] = (f32x2v){__builtin_amdgcn_cosf(fr), __builtin_amdgcn_sinf(fr)}; }
    END_PHASE

#pragma nounroll
    for (int f = 0; f < 4; ++f) {
        const int layer = f >> 1;
        const int ni = f + (f > 0 ? 1 : 0) + (f > 2 ? 1 : 0);
        BEGIN_PHASE
            pg8::Gemm gm{XN, (const bf16*)(ws + WS_WFI + (size_t)f * WFI_SZ), M, 2 * FF, DM, DM}; pg8::StaticOrder S; S.init(M, 2 * FF, G, bx);
            pg8::EpiSwiglu E{(unsigned)WS_BIG, FF, (unsigned)(WS_RSS + (size_t)ni * RSS_SZ), 1.f / DM};
#ifndef DIS_G0
            pg8::gemm_phase<pg8::EpiSwiglu, pg8::StaticOrder, true, true>(lds, gm, S, E);
#endif
        END_PHASE
        BEGIN_PHASE
            pg8::Gemm gm{BIG, (const bf16*)(ws + WS_WFO + (size_t)f * WFO_SZ), M, DM, FF, FF}; pg8::StaticOrder S; S.init(M, DM, G, bx);
            pg8::EpiResid E{f == 0 ? 1 : 0, 0.5f, (unsigned)(WS_RSS + (size_t)(ni + 1) * RSS_SZ)};
#ifndef DIS_G1
            pg8::gemm_phase<pg8::EpiResid, pg8::StaticOrder, true, true>(lds, gm, S, E);
#endif
        END_PHASE
        if ((f & 1) == 0) {
            const int mi = 1 + 3 * layer;
            if (layer == 0) {
                BEGIN_PHASE
                    pg8::Gemm gm{XN, (const bf16*)(ws + WS_WSI), M, 2 * SW, DM, DM}; pg8::StaticOrder S; S.init(M, 2 * SW, G, bx);
                    pg8::EpiBf16<1, 1> E{(unsigned)WS_BIG, SW, SW, (unsigned)((size_t)M * SW), (unsigned)(WS_RSS + (size_t)mi * RSS_SZ), 1.f / DM, (unsigned)WS_VSUM, (unsigned)WS_VSQ};
#ifndef DIS_G2
                    pg8::gemm_phase<pg8::EpiBf16<1, 1>, pg8::StaticOrder, true, true>(lds, gm, S, E);
#endif
                END_PHASE
                BEGIN_PHASE
#ifndef DIS_SGU
                    sgu_spatial_phase(lds, BIG, BIG + (size_t)M * SW, BIG + (size_t)M * SW, (const u64_t*)(ws + WS_VSUM), (const u64_t*)(ws + WS_VSQ), IN_F(10), IN_F(11), IN_F(12), IN_F(13), G, bx);
#endif
                END_PHASE
            } else {
#define PROJ ((bf16*)(ws + WS_PROJ))
#define KR ((bf16*)(ws + WS_KR))
#define Qb BIG
#define KVb (BIG + (size_t)M * QUP_N)
#define Ob ((bf16*)(ws + WS_O))
                BEGIN_PHASE
                    pg8::Gemm gm{XN, (const bf16*)(ws + WS_WMI), M, 1024, DM, DM}; pg8::StaticOrder S; S.init(M, 1024, G, bx);
                    pg8::EpiBf16<0, 2> E{(unsigned)WS_PROJ, MLA_INP, 0, 0u, (unsigned)(WS_RSS + (size_t)mi * RSS_SZ), 1.f / DM, (unsigned)WS_QSS, (unsigned)WS_KVSS};
#ifndef DIS_G3
                    pg8::gemm_phase<pg8::EpiBf16<0, 2>, pg8::StaticOrder, true, true>(lds, gm, S, E);
#endif
                    { pg8::Gemm gs{XN, (const bf16*)(ws + WS_WMI) + (size_t)1024 * DM, M, 1024, 512, DM, DM, 1024u, 1024u}; pg8::StaticOrder S2; S2.init(M, 1024, G, bx);
                      pg8::EpiPartial E2{(unsigned)WS_O};
                      pg8::gemm_phase<pg8::EpiPartial, pg8::StaticOrder, true, true>(lds, gs, S2, E2); }
                END_PHASE
                BEGIN_PHASE
                    for (int m = gw; m < M; m += NGW) if (lane < 32) { const float* part = (const float*)(ws + WS_O) + (size_t)m * 64;
                        const float rs = __builtin_amdgcn_rsqf(stat_get(((const u64_t*)(ws + WS_RSS + (size_t)mi * RSS_SZ))[m]) * (1.f / DM) + EPS);
                        const float x1 = ((part[lane] + part[(size_t)M * 64 + lane]) + (part[(size_t)2 * M * 64 + lane] + part[(size_t)3 * M * 64 + lane])) * rs;
                        const float x2 = ((part[32 + lane] + part[(size_t)M * 64 + 32 + lane]) + (part[(size_t)2 * M * 64 + 32 + lane] + part[(size_t)3 * M * 64 + 32 + lane])) * rs;
                        const f32x2v cs = TAB[(size_t)m * 32 + lane]; const unsigned w = pk2(x1 * cs.x - x2 * cs.y, x1 * cs.y + x2 * cs.x);
                        KR[(size_t)m * 64 + lane] = (bf16)(w & 0xffffu); KR[(size_t)m * 64 + 32 + lane] = (bf16)(w >> 16); }
                    { pg8::Gemm gm{PROJ, (const bf16*)(ws + WS_WQU), M, QUP_N, 512, MLA_INP}; pg8::StaticOrder S; S.init(M, QUP_N, G, bx);
                      pg8::EpiBf16<0, 0> E{(unsigned)WS_BIG, QUP_N, 0, 0u, (unsigned)WS_QSS, 1.f / 512, 0u, 0u};
#ifndef DIS_G4
                      pg8::gemm_phase<pg8::EpiBf16<0, 0>, pg8::StaticOrder, true, true>(lds, gm, S, E);
#endif
                    }
                    { pg8::Gemm gm{PROJ + 512, (const bf16*)(ws + WS_WKV), M, KVUP_N, 512, MLA_INP}; pg8::StaticOrder S; S.init(M, KVUP_N, G, bx);
                      pg8::EpiBf16<0, 0> E{(unsigned)(WS_BIG + (size_t)M * QUP_N * 2), KVUP_N, 0, 0u, (unsigned)WS_KVSS, 1.f / 512, 0u, 0u};
#ifndef DIS_G5
                      pg8::gemm_phase<pg8::EpiBf16<0, 0>, pg8::StaticOrder, true, true>(lds, gm, S, E);
#endif
                    }
                END_PHASE
                BEGIN_PHASE
#ifndef DIS_ATTN
                    attn_phase(lds, Qb, KVb, KR, TAB, Ob, G, bx);
#endif
                END_PHASE
            }
            BEGIN_PHASE
                pg8::Gemm gm{layer ? Ob : BIG + (size_t)M * SW, (const bf16*)(ws + (layer ? WS_WMO : WS_WSO)), M, DM, layer ? DM : SW, layer ? DM : SW}; pg8::StaticOrder S; S.init(M, DM, G, bx);
                pg8::EpiResid E{0, 1.0f, (unsigned)(WS_RSS + (size_t)(mi + 1) * RSS_SZ)};
#ifndef DIS_G6
                pg8::gemm_phase<pg8::EpiResid, pg8::StaticOrder, true, true>(lds, gm, S, E);
#endif
            END_PHASE
        }
    }
    BEGIN_PHASE
        const float* g = IN_F(21); const u64_t* rss = (const u64_t*)(ws + WS_RSS + 6 * RSS_SZ);
        for (int m = gw; m < M; m += NGW) rms_row_out(XN + (size_t)m * DM, g, stat_get(rss[m]), out + (size_t)m * DM, lane);
    END_PHASE
#undef BEGIN_PHASE
#undef END_PHASE
}

extern "C" void kernel_launch(void* const* d_in, const int* in_sizes, int n_in, void* d_out, int out_size, void* d_ws, size_t ws_size, hipStream_t stream) {
    static int grid = 0;
    if (grid == 0) {
        if (n_in != 22 || in_sizes[0] != M * DM || out_size != M * DM || ws_size < WS_END) { fprintf(stderr, "kernel_launch: unexpected shapes (n_in %d, in0 %d, out %d, ws %zu)\n", n_in, n_in > 0 ? in_sizes[0] : -1, out_size, ws_size); grid = -1; return; }
        int dev = 0, cus = 0, per_cu = 0;
        if (hipGetDevice(&dev) != hipSuccess || hipDeviceGetAttribute(&cus, hipDeviceAttributeMultiprocessorCount, dev) != hipSuccess) { grid = -1; return; }
        if (hipFuncSetAttribute((const void*)mk_fwd, hipFuncAttributeMaxDynamicSharedMemorySize, LDS_BYTES) != hipSuccess) { fprintf(stderr, "kernel_launch: hipFuncSetAttribute failed\n"); grid = -1; return; }
        if (hipOccupancyMaxActiveBlocksPerMultiprocessor(&per_cu, (const void*)mk_fwd, NTHR, LDS_BYTES) != hipSuccess || per_cu < 1) { fprintf(stderr, "kernel_launch: occupancy query says %d blocks per CU\n", per_cu); per_cu = 1; }
        (void)hipGetLastError();
        grid = cus;
    }
    if (grid < 0) return;
    Args a{};
    for (int i = 0; i < 22; ++i) a.in[i] = d_in[i];
    a.out = (float*)d_out; a.ws = (unsigned char*)d_ws;
#if MK_PER_PHASE
    for (int ph = 0; ph < NPHASES; ++ph) { a.ph_lo = ph; a.ph_hi = ph + 1; a.coop = 0;
        hipLaunchKernelGGL(mk_fwd, dim3(grid), dim3(NTHR), LDS_BYTES, stream, a); }
#else
    a.ph_lo = 0; a.ph_hi = NPHASES; a.coop = 1;
    void* args[] = {&a};
    hipError_t e = hipLaunchCooperativeKernel((const void*)mk_fwd, dim3(grid), dim3(NTHR), args, LDS_BYTES, stream);
    if (e != hipSuccess) fprintf(stderr, "kernel_launch: cooperative launch failed: %s (grid %d)\n", hipGetErrorString(e), grid);
#endif
}
```
